# Optimizing an MI355X kernel written in HIP

```python
import math
import jax, jax.numpy as jnp
from jax import lax
import numpy as np

D_MODEL = 1024
BATCH = 16
SEQ = 2048
DEPTH = 4

GRID_W = 64
CTX_LEN = 256
N_MIXERS = 3
N_LAYERS_A = (DEPTH + 2) // 3
N_LAYERS_B = (DEPTH + 1) // 3
N_LAYERS_C = DEPTH // 3
HEAD_DIM = 64
DIFF_HEADS = D_MODEL // (2 * HEAD_DIM)
DIFF_V_DIM = 2 * HEAD_DIM
GQA_HEADS = D_MODEL // HEAD_DIM
GQA_KV_HEADS = GQA_HEADS // 4
GQA_GROUP = GQA_HEADS // GQA_KV_HEADS
Q_BLOCK = 128
WINDOW = 128
D_FF = 256 * ((8 * D_MODEL // 3 + 255) // 256)
CONV_W = 3
ROPE_THETA = 10000.0
EPS = 1e-6
ATTN_SCALE = HEAD_DIM ** -0.5

kernel_name = 'hybrid_diff_grid_window_convffn_trunk'


def rms_norm(x, g):
    xf = x.astype(jnp.float32)
    y = xf * lax.rsqrt(jnp.mean(xf * xf, axis=-1, keepdims=True) + EPS)
    return (y * g.astype(jnp.float32)).astype(x.dtype)


def modulate(h, shift, scale):
    return h * (1.0 + scale) + shift


def grid_rope_tables(rows):
    t = jnp.arange(rows * GRID_W)
    row = (t // GRID_W).astype(jnp.float32)
    col = (t % GRID_W).astype(jnp.float32)
    n_freq = HEAD_DIM // 4
    inv_freq = ROPE_THETA ** (-jnp.arange(n_freq, dtype=jnp.float32) / n_freq)
    ang = jnp.concatenate([row[:, None] * inv_freq, col[:, None] * inv_freq], axis=-1)
    return jnp.cos(ang), jnp.sin(ang)


def apply_rope(x, cos, sin):
    half = x.shape[-1] // 2
    shape = (1, cos.shape[0]) + (1,) * (x.ndim - 3) + (cos.shape[1],)
    cs = cos.reshape(shape).astype(x.dtype)
    sn = sin.reshape(shape).astype(x.dtype)
    x1, x2 = x[..., :half], x[..., half:]
    return jnp.concatenate([x1 * cs - x2 * sn, x2 * cs + x1 * sn], axis=-1)


def to_blocks(t):
    b, l = t.shape[:2]
    t = t.reshape((b, l // Q_BLOCK, Q_BLOCK) + t.shape[2:])
    return jnp.moveaxis(t, 1, 0)


def from_blocks(t):
    t = jnp.moveaxis(t, 0, 1)
    return t.reshape((t.shape[0], t.shape[1] * t.shape[2]) + t.shape[3:])


def diff_proj(h, w_qkv, qk_g):
    b, l, _ = h.shape
    q, k, v = jnp.split(h @ w_qkv, 3, axis=-1)
    q = rms_norm(q.reshape(b, l, DIFF_HEADS, 2, HEAD_DIM), qk_g[0])
    k = rms_norm(k.reshape(b, l, DIFF_HEADS, 2, HEAD_DIM), qk_g[1])
    v = v.reshape(b, l, DIFF_HEADS, DIFF_V_DIM)
    return q, k, v


def diff_core(q, k, v, lam):
    s = jnp.einsum('bqhcd,bshcd->bhcqs', q, k).astype(jnp.float32) * ATTN_SCALE
    p = jax.nn.softmax(s, axis=-1)
    w = (p[:, :, 0] - lam * p[:, :, 1]).astype(v.dtype)
    return jnp.einsum('bhqs,bshe->bqhe', w, v)


def diff_attention(h_lat, h_ctx, w_qkv, qk_g, lam_p, head_g, w_o, lam_init, cos, sin, need_ctx):
    q_l, k_l, v_l = diff_proj(h_lat, w_qkv, qk_g)
    q_c, k_c, v_c = diff_proj(h_ctx, w_qkv, qk_g)
    q_l = apply_rope(q_l, cos, sin)
    k_l = apply_rope(k_l, cos, sin)
    lq = lam_p.astype(jnp.float32)
    lam = jnp.exp(jnp.sum(lq[0] * lq[1])) - jnp.exp(jnp.sum(lq[2] * lq[3])) + lam_init
    k_all = jnp.concatenate([k_l, k_c], axis=1)
    v_all = jnp.concatenate([v_l, v_c], axis=1)
    o_l = from_blocks(lax.map(lambda qb: diff_core(qb, k_all, v_all, lam), to_blocks(q_l)))

    def finish(o):
        b, l = o.shape[:2]
        o = rms_norm(o, head_g) * (1.0 - lam_init)
        return o.reshape(b, l, DIFF_HEADS * DIFF_V_DIM) @ w_o

    y_l = finish(o_l)
    y_c = finish(diff_core(q_c, k_c, v_c, lam)) if need_ctx else None
    return y_l, y_c


def gqa_proj(h, w_qkv, qk_g):
    b, l, _ = h.shape
    q, k, v = jnp.split(h @ w_qkv, [GQA_HEADS * HEAD_DIM, (GQA_HEADS + GQA_KV_HEADS) * HEAD_DIM], axis=-1)
    q = rms_norm(q.reshape(b, l, GQA_KV_HEADS, GQA_GROUP, HEAD_DIM), qk_g[0])
    k = rms_norm(k.reshape(b, l, GQA_KV_HEADS, HEAD_DIM), qk_g[1])
    v = v.reshape(b, l, GQA_KV_HEADS, HEAD_DIM)
    return q, k, v


def merge_heads(o):
    return o.reshape(o.shape[0], o.shape[1], GQA_HEADS * HEAD_DIM)


def gqa_dense_core(q, k, v):
    s = jnp.einsum('bqkgd,bskd->bkgqs', q, k).astype(jnp.float32) * ATTN_SCALE
    p = jax.nn.softmax(s, axis=-1).astype(v.dtype)
    return jnp.einsum('bkgqs,bskd->bqkgd', p, v)


def grid_gqa_attention(h_lat, h_ctx, w_qkv, qk_g, w_o, cos, sin, need_ctx):
    q_l, k_l, v_l = gqa_proj(h_lat, w_qkv, qk_g)
    q_c, k_c, v_c = gqa_proj(h_ctx, w_qkv, qk_g)
    q_l = apply_rope(q_l, cos, sin)
    k_l = apply_rope(k_l, cos, sin)
    k_all = jnp.concatenate([k_l, k_c], axis=1)
    v_all = jnp.concatenate([v_l, v_c], axis=1)
    o_l = from_blocks(lax.map(lambda qb: gqa_dense_core(qb, k_all, v_all), to_blocks(q_l)))
    y_l = merge_heads(o_l) @ w_o
    y_c = merge_heads(gqa_dense_core(q_c, k_c, v_c)) @ w_o if need_ctx else None
    return y_l, y_c


def window_gqa_attention(h_lat, h_ctx, w_qkv, qk_g, sink, w_o, cos, sin, need_ctx):
    q_l, k_l, v_l = gqa_proj(h_lat, w_qkv, qk_g)
    q_c, k_c, v_c = gqa_proj(h_ctx, w_qkv, qk_g)
    q_l = apply_rope(q_l, cos, sin)
    k_l = apply_rope(k_l, cos, sin)
    n_lat = h_lat.shape[1]
    n_ctx = h_ctx.shape[1]
    band = Q_BLOCK + 2 * WINDOW
    pad = ((0, 0), (WINDOW, WINDOW), (0, 0), (0, 0))
    k_pad = jnp.pad(k_l, pad)
    v_pad = jnp.pad(v_l, pad)
    sink_f = sink.astype(jnp.float32).reshape(GQA_KV_HEADS, GQA_GROUP)[None, :, :, None, None]
    q_off = jnp.arange(Q_BLOCK)[:, None]
    k_off = jnp.arange(band)[None, :]
    rel = k_off - q_off
    in_band = (rel >= 0) & (rel <= 2 * WINDOW)

    def block(args):
        i, qb = args
        kb = lax.dynamic_slice_in_dim(k_pad, i * Q_BLOCK, band, axis=1)
        vb = lax.dynamic_slice_in_dim(v_pad, i * Q_BLOCK, band, axis=1)
        kpos = i * Q_BLOCK - WINDOW + k_off
        mask = in_band & (kpos >= 0) & (kpos < n_lat)
        s_w = jnp.einsum('bqkgd,bskd->bkgqs', qb, kb).astype(jnp.float32) * ATTN_SCALE
        s_w = jnp.where(mask, s_w, -jnp.inf)
        s_c = jnp.einsum('bqkgd,bskd->bkgqs', qb, k_c).astype(jnp.float32) * ATTN_SCALE
        s_s = jnp.broadcast_to(sink_f, s_w.shape[:-1] + (1,))
        p = jax.nn.softmax(jnp.concatenate([s_w, s_c, s_s], axis=-1), axis=-1).astype(vb.dtype)
        return (jnp.einsum('bkgqs,bskd->bqkgd', p[..., :band], vb)
                + jnp.einsum('bkgqs,bskd->bqkgd', p[..., band:band + n_ctx], v_c))

    nb = n_lat // Q_BLOCK
    o_l = from_blocks(lax.map(block, (jnp.arange(nb), to_blocks(q_l))))
    y_l = merge_heads(o_l) @ w_o
    y_c = None
    if need_ctx:
        s = jnp.einsum('bqkgd,bskd->bkgqs', q_c, k_c).astype(jnp.float32) * ATTN_SCALE
        s_s = jnp.broadcast_to(sink_f, s.shape[:-1] + (1,))
        p = jax.nn.softmax(jnp.concatenate([s, s_s], axis=-1), axis=-1)[..., :n_ctx].astype(v_c.dtype)
        y_c = merge_heads(jnp.einsum('bkgqs,bskd->bqkgd', p, v_c)) @ w_o
    return y_l, y_c


def conv_ffn(h, w_up, conv_w, conv_b, w_down):
    n = h.shape[1]
    u = h @ w_up
    half = CONV_W // 2
    up = jnp.pad(u, ((0, 0), (half, half), (0, 0)))
    u = sum(up[:, j:j + n] * conv_w[j] for j in range(CONV_W)) + conv_b
    gate, val = jnp.split(u, 2, axis=-1)
    return (jax.nn.silu(gate) * val) @ w_down


def setup_inputs(seed: int = 0) -> dict:
    key = jax.random.key(seed)
    ks = iter(jax.random.split(key, 32))
    f32 = jnp.float32
    nrm = lambda shape, s: jax.random.normal(next(ks), shape, f32) * s
    gain = lambda shape: 1.0 + 0.02 * jax.random.normal(next(ks), shape, f32)
    d = D_MODEL
    qkv_gqa = (GQA_HEADS + 2 * GQA_KV_HEADS) * HEAD_DIM
    return {
        'x': nrm((BATCH, SEQ, d), 1.0),
        'c': nrm((BATCH, d), 1.0),
        'ctx': nrm((BATCH, CTX_LEN, d), 1.0),
        'c_ctx': nrm((d,), 1.0),
        'adaln_w': nrm((DEPTH, d, 6 * d), 0.5 * d ** -0.5),
        'adaln_b': nrm((DEPTH, 6 * d), 0.01),
        'norm1_g': gain((DEPTH, d)),
        'norm2_g': gain((DEPTH, d)),
        'ffn_w_up': nrm((DEPTH, d, 2 * D_FF), d ** -0.5),
        'ffn_conv_w': nrm((DEPTH, CONV_W, 2 * D_FF), CONV_W ** -0.5),
        'ffn_conv_b': nrm((DEPTH, 2 * D_FF), 0.01),
        'ffn_w_down': nrm((DEPTH, D_FF, d), D_FF ** -0.5),
        'a_w_qkv': nrm((N_LAYERS_A, d, 3 * DIFF_HEADS * 2 * HEAD_DIM), d ** -0.5),
        'a_qk_g': gain((N_LAYERS_A, 2, HEAD_DIM)),
        'a_lambda': nrm((N_LAYERS_A, 4, HEAD_DIM), 0.1),
        'a_head_g': gain((N_LAYERS_A, DIFF_V_DIM)),
        'a_w_o': nrm((N_LAYERS_A, DIFF_HEADS * DIFF_V_DIM, d), (DIFF_HEADS * DIFF_V_DIM) ** -0.5),
        'b_w_qkv': nrm((N_LAYERS_B, d, qkv_gqa), d ** -0.5),
        'b_qk_g': gain((N_LAYERS_B, 2, HEAD_DIM)),
        'b_w_o': nrm((N_LAYERS_B, GQA_HEADS * HEAD_DIM, d), (GQA_HEADS * HEAD_DIM) ** -0.5),
        'c_w_qkv': nrm((N_LAYERS_C, d, qkv_gqa), d ** -0.5),
        'c_qk_g': gain((N_LAYERS_C, 2, HEAD_DIM)),
        'c_sink': nrm((N_LAYERS_C, GQA_HEADS), 0.5),
        'c_w_o': nrm((N_LAYERS_C, GQA_HEADS * HEAD_DIM, d), (GQA_HEADS * HEAD_DIM) ** -0.5),
    }


def reference(x, c, ctx, c_ctx, adaln_w, adaln_b, norm1_g, norm2_g, ffn_w_up, ffn_conv_w, ffn_conv_b,
              ffn_w_down, a_w_qkv, a_qk_g, a_lambda, a_head_g, a_w_o, b_w_qkv, b_qk_g, b_w_o,
              c_w_qkv, c_qk_g, c_sink, c_w_o):
    ROWS = x.shape[1] // GRID_W
    cos, sin = grid_rope_tables(ROWS)
    h_ctx = ctx
    sc = jax.nn.silu(c)
    sc_ctx = jax.nn.silu(c_ctx)
    for i in range(DEPTH):
        last = i == DEPTH - 1
        j = i // N_MIXERS
        kind = i % N_MIXERS
        mod_l = (sc @ adaln_w[i] + adaln_b[i])[:, None, :]
        mod_c = (sc_ctx @ adaln_w[i] + adaln_b[i])[None, None, :]
        sh1, sc1, g1, sh2, sc2, g2 = jnp.split(mod_l, 6, axis=-1)
        csh1, csc1, cg1, csh2, csc2, cg2 = jnp.split(mod_c, 6, axis=-1)
        hn_l = modulate(rms_norm(x, norm1_g[i]), sh1, sc1)
        hn_c = modulate(rms_norm(h_ctx, norm1_g[i]), csh1, csc1)
        if kind == 0:
            lam_init = 0.8 - 0.6 * math.exp(-0.3 * i)
            y_l, y_c = diff_attention(hn_l, hn_c, a_w_qkv[j], a_qk_g[j], a_lambda[j], a_head_g[j], a_w_o[j],
                                      lam_init, cos, sin, not last)
        elif kind == 1:
            y_l, y_c = grid_gqa_attention(hn_l, hn_c, b_w_qkv[j], b_qk_g[j], b_w_o[j], cos, sin, not last)
        else:
            y_l, y_c = window_gqa_attention(hn_l, hn_c, c_w_qkv[j], c_qk_g[j], c_sink[j], c_w_o[j],
                                            cos, sin, not last)
        x = x + g1 * y_l
        x = x + g2 * conv_ffn(modulate(rms_norm(x, norm2_g[i]), sh2, sc2),
                              ffn_w_up[i], ffn_conv_w[i], ffn_conv_b[i], ffn_w_down[i])
        if not last:
            h_ctx = h_ctx + cg1 * y_c
            h_ctx = h_ctx + cg2 * conv_ffn(modulate(rms_norm(h_ctx, norm2_g[i]), csh2, csc2),
                                           ffn_w_up[i], ffn_conv_w[i], ffn_conv_b[i], ffn_w_down[i])
    return x
```

```cpp
#include <hip/hip_runtime.h>
#include <hip/hip_cooperative_groups.h>
#include <cstdio>
#include <cstdint>
namespace cg = cooperative_groups;
#define LAS __attribute__((address_space(3)))
#define DI __device__ __forceinline__
constexpr int DM = 1024, NBATCH = 16, SEQL = 2048, CTXL = 256, DEPTH = 4;
constexpr int MLAT = NBATCH * SEQL, MCTX = NBATCH * CTXL, MTOT = MLAT + MCTX;
constexpr int DFF = 2816, NUP = 2 * DFF, MODW = 6 * DM, NMODB = NBATCH + 1;
constexpr float EPSN = 1e-6f;
constexpr float QSCALE = 0.125f * 1.4426950408889634f;
typedef float f32x2_t __attribute__((ext_vector_type(2)));
typedef __bf16 bf16x2_t __attribute__((ext_vector_type(2)));
DI unsigned pk2(float lo, float hi) { f32x2_t v = {lo, hi}; bf16x2_t b = __builtin_convertvector(v, bf16x2_t); return __builtin_bit_cast(unsigned, b); }
DI float bf_lo(unsigned u) { return __uint_as_float(u << 16); }
DI float bf_hi(unsigned u) { return __uint_as_float(u & 0xffff0000u); }
DI float silu_f(float g) { return g * __builtin_amdgcn_rcpf(1.f + __builtin_amdgcn_exp2f(-1.4426950408889634f * g)); }
namespace pg8 {
#define PG8_LAS __attribute__((address_space(3)))
typedef unsigned short bf16_t;
typedef short bf16x8 __attribute__((ext_vector_type(8)));
typedef float f32x4 __attribute__((ext_vector_type(4)));
typedef unsigned u32x4 __attribute__((ext_vector_type(4)));
constexpr int BM = 256, BK = 64, HALF = 128, HTB = HALF * BK * 2  , STAGE_BYTES = 8 * HTB, NXCD = 8, WGM = 8;

__host__ __device__ __forceinline__ int lds_byte(int r, int c) { const int st = (r >> 4) * 2 + (c >> 5), rr = r & 15, cc = c & 31, ob = rr * 64 + cc * 2; return st * 1024 + (ob ^ (((ob >> 9) & 1) << 5)); }
__host__ __device__ __forceinline__ void stage_rc(int b, int& R, int& C) { const int st = b / 1024, sb = b % 1024, swz = sb ^ (((sb >> 9) & 1) << 5); R = (st >> 1) * 16 + swz / 64; C = (st & 1) * 32 + (swz % 64) / 2; }
__host__ __device__ __forceinline__ int perm32(int rho) { const int n = rho >> 4, i = rho & 15; return 8 * (i >> 2) + 4 * n + (i & 3); }

struct Unit { int pm, pn; };
struct Gemm { const bf16_t* A; const bf16_t* Bt; int M, N, K; };

struct StaticOrder {
    int nM, nN, nwg, G, c;
    __host__ __device__ void init(int M, int N, int G_, int c_) { nM = M / BM; nN = N / BM; nwg = nM * nN; G = G_; c = c_; }
    __host__ __device__ bool next(int i, Unit& u) const {
        const long L = (long)i * G + c; if (L >= nwg) return false;
        int wgid = (int)L; { const int q = nwg / NXCD, r = nwg % NXCD, xcd = wgid % NXCD, off = wgid / NXCD; wgid = (xcd < r ? xcd * (q + 1) : r * (q + 1) + (xcd - r) * q) + off; }
        const int nig = WGM * nN, gid = wgid / nig, fm = gid * WGM, gsz = (nM - fm) < WGM ? (nM - fm) : WGM;
        u.pm = fm + ((wgid % nig) % gsz); u.pn = (wgid % nig) / gsz; return true;
    }
    __device__ __forceinline__ void a_ready(const Unit&) const {}
    __device__ __forceinline__ void done(const Unit&) const {}
};

struct EpiQKV {
    static constexpr bool PERM = true, AFTER_DRAIN = false;
    bf16_t* O; int ldc; const float* qg; const float* kg; const float* rcos; const float* rsin; int nq_tiles, nk_tiles;
    __device__ __forceinline__ void operator()(const f32x4 (&acc)[2][2][4][2], const Unit& u, int wr, int wc, int fr, int fq, PG8_LAS unsigned char*) const {
        const int kind = u.pn < nq_tiles ? 0 : (u.pn < nq_tiles + nk_tiles ? 1 : 2);
        const int col0 = u.pn * BM + 64 * wc + 8 * fq;
        if (kind == 2) {
#pragma unroll
            for (int ai = 0; ai < 2; ++ai)
#pragma unroll
                for (int m = 0; m < 4; ++m) { bf16_t* rowp = O + (size_t)(u.pm * BM + ai * HALF + wr * 64 + m * 16 + fr) * ldc + col0;
#pragma unroll
                    for (int bj = 0; bj < 2; ++bj) { const f32x4 v0 = acc[ai][bj][m][0], v1 = acc[ai][bj][m][1]; u32x4 w; w.x = pk2(v0[0], v0[1]); w.y = pk2(v0[2], v0[3]); w.z = pk2(v1[0], v1[1]); w.w = pk2(v1[2], v1[3]);
                        *(u32x4*)(rowp + 32 * bj) = w; } }
            return;
        }
        const float* g = kind == 0 ? qg : kg; const float qs = kind == 0 ? QSCALE : 1.f;
        f32x4 g0[2], g1[2];
#pragma unroll
        for (int n = 0; n < 2; ++n) { g0[n] = *(const f32x4*)(g + 8 * fq + 4 * n); g1[n] = *(const f32x4*)(g + 32 + 8 * fq + 4 * n); }
#pragma unroll
        for (int ai = 0; ai < 2; ++ai)
#pragma unroll
            for (int m = 0; m < 4; ++m) {
                const int row = u.pm * BM + ai * HALF + wr * 64 + m * 16 + fr;
                float ss = 0.f;
#pragma unroll
                for (int bj = 0; bj < 2; ++bj)
#pragma unroll
                    for (int n = 0; n < 2; ++n) { const f32x4 x = acc[ai][bj][m][n]; ss += (x[0] * x[0] + x[1] * x[1]) + (x[2] * x[2] + x[3] * x[3]); }
                ss += __shfl_xor(ss, 16); ss += __shfl_xor(ss, 32);
                const float rstd = __builtin_amdgcn_rsqf(ss * (1.f / 64.f) + EPSN) * qs;
                f32x4 cs[2], sn[2];
                if (row < MLAT) { const int t = row & (SEQL - 1);
#pragma unroll
                    for (int n = 0; n < 2; ++n) { cs[n] = *(const f32x4*)(rcos + t * 32 + 8 * fq + 4 * n); sn[n] = *(const f32x4*)(rsin + t * 32 + 8 * fq + 4 * n); } }
                else { cs[0] = cs[1] = (f32x4){1.f, 1.f, 1.f, 1.f}; sn[0] = sn[1] = (f32x4){0.f, 0.f, 0.f, 0.f}; }
                f32x4 o1[2], o2[2];
#pragma unroll
                for (int n = 0; n < 2; ++n) { const f32x4 y1 = acc[ai][0][m][n] * rstd * g0[n], y2 = acc[ai][1][m][n] * rstd * g1[n]; o1[n] = y1 * cs[n] - y2 * sn[n]; o2[n] = y2 * cs[n] + y1 * sn[n]; }
                bf16_t* rowp = O + (size_t)row * ldc + col0;
                u32x4 w; w.x = pk2(o1[0][0], o1[0][1]); w.y = pk2(o1[0][2], o1[0][3]); w.z = pk2(o1[1][0], o1[1][1]); w.w = pk2(o1[1][2], o1[1][3]); *(u32x4*)rowp = w;
                w.x = pk2(o2[0][0], o2[0][1]); w.y = pk2(o2[0][2], o2[0][3]); w.z = pk2(o2[1][0], o2[1][1]); w.w = pk2(o2[1][2], o2[1][3]); *(u32x4*)(rowp + 32) = w;
            }
    }
};
struct EpiResid {
    static constexpr bool PERM = false, AFTER_DRAIN = false;
    const float* in_lat; const float* in_ctx; float* out; const float* gate;
    __device__ __forceinline__ void operator()(const f32x4 (&acc)[2][2][4][2], const Unit& u, int wr, int wc, int fr, int fq, PG8_LAS unsigned char*) const {
        const int col0 = u.pn * BM + wc * 32 + 4 * fq;
        const int bb = u.pm < MLAT / BM ? (u.pm >> 3) : NBATCH;
        const float* src = u.pm < MLAT / BM ? in_lat : in_ctx;
        f32x4 gv[2][2];
#pragma unroll
        for (int bj = 0; bj < 2; ++bj)
#pragma unroll
            for (int n = 0; n < 2; ++n) gv[bj][n] = *(const f32x4*)(gate + (size_t)bb * MODW + col0 + bj * HALF + n * 16);
#pragma unroll
        for (int ai = 0; ai < 2; ++ai)
#pragma unroll
            for (int m = 0; m < 4; ++m) { const size_t off = (size_t)(u.pm * BM + ai * HALF + wr * 64 + m * 16 + fr) * DM + col0;
#pragma unroll
                for (int bj = 0; bj < 2; ++bj)
#pragma unroll
                    for (int n = 0; n < 2; ++n) { const f32x4 xv = *(const f32x4*)(src + off + bj * HALF + n * 16); *(f32x4*)(out + off + bj * HALF + n * 16) = xv + gv[bj][n] * acc[ai][bj][m][n]; } }
    }
};
struct EpiConv {
    static constexpr bool PERM = true, AFTER_DRAIN = false;
    bf16_t* ACT; float* HB; const float* cw; const float* cb;
    __device__ __forceinline__ void operator()(const f32x4 (&acc)[2][2][4][2], const Unit& u, int wr, int wc, int fr, int fq, PG8_LAS unsigned char* lds) const {
        PG8_LAS float* H = (PG8_LAS float*)(lds + STAGE_BYTES);
        const int chl = 32 * wc + 8 * fq, lane = 16 * fq + fr;
#pragma unroll
        for (int ai = 0; ai < 2; ++ai) { const int seg = 2 * ai + wr;
            if (fr == 0) {
#pragma unroll
                for (int bj = 0; bj < 2; ++bj)
#pragma unroll
                    for (int n = 0; n < 2; ++n) *(PG8_LAS f32x4*)(H + ((seg * 2 + 0) * 2 + bj) * 128 + chl + 4 * n) = acc[ai][bj][0][n]; }
            if (fr == 15) {
#pragma unroll
                for (int bj = 0; bj < 2; ++bj)
#pragma unroll
                    for (int n = 0; n < 2; ++n) *(PG8_LAS f32x4*)(H + ((seg * 2 + 1) * 2 + bj) * 128 + chl + 4 * n) = acc[ai][bj][3][n]; } }
        if (wr == 0 && fr < 2) { float* hb = HB + ((size_t)u.pm * 4 + fr) * NUP + 128 * u.pn + chl;
#pragma unroll
            for (int bj = 0; bj < 2; ++bj)
#pragma unroll
                for (int n = 0; n < 2; ++n) *(f32x4*)(hb + bj * DFF + 4 * n) = acc[0][bj][0][n]; }
        if (wr == 1 && fr >= 14) { float* hb = HB + ((size_t)u.pm * 4 + (fr - 12)) * NUP + 128 * u.pn + chl;
#pragma unroll
            for (int bj = 0; bj < 2; ++bj)
#pragma unroll
                for (int n = 0; n < 2; ++n) *(f32x4*)(hb + bj * DFF + 4 * n) = acc[1][bj][3][n]; }
        asm volatile("s_waitcnt lgkmcnt(0)" ::: "memory"); __builtin_amdgcn_s_barrier(); asm volatile("" ::: "memory");
        const int src_prev = (lane & 48) | ((fr + 15) & 15), src_next = (lane & 48) | ((fr + 1) & 15);
#pragma unroll
        for (int n = 0; n < 2; ++n) {
            const int colg = 128 * u.pn + chl + 4 * n;
#pragma unroll
            for (int ai = 0; ai < 2; ++ai) { const int seg = 2 * ai + wr;
                f32x4 cg[4];
#pragma unroll
                for (int bj = 0; bj < 2; ++bj) {
                    const f32x4 w0 = *(const f32x4*)(cw + bj * DFF + colg), w1 = *(const f32x4*)(cw + NUP + bj * DFF + colg), w2 = *(const f32x4*)(cw + 2 * NUP + bj * DFF + colg), bs = *(const f32x4*)(cb + bj * DFF + colg);
                    f32x4 hp = (f32x4){0.f, 0.f, 0.f, 0.f}, hn = hp;
                    if (seg > 0) hp = *(const PG8_LAS f32x4*)(H + (((seg - 1) * 2 + 1) * 2 + bj) * 128 + chl + 4 * n);
                    if (seg < 3) hn = *(const PG8_LAS f32x4*)(H + (((seg + 1) * 2 + 0) * 2 + bj) * 128 + chl + 4 * n);
#pragma unroll
                    for (int e = 0; e < 4; ++e) {
                        float v[4], rr[4], rl[4];
#pragma unroll
                        for (int m = 0; m < 4; ++m) { v[m] = acc[ai][bj][m][n][e]; rr[m] = __shfl(v[m], src_prev); rl[m] = __shfl(v[m], src_next); }
#pragma unroll
                        for (int m = 0; m < 4; ++m) {
                            const float pv = fr != 0 ? rr[m] : (m > 0 ? rr[m > 0 ? m - 1 : 0] : hp[e]);
                            const float nv = fr != 15 ? rl[m] : (m < 3 ? rl[m < 3 ? m + 1 : 3] : hn[e]);
                            const float cvv = w0[e] * pv + w1[e] * v[m] + w2[e] * nv + bs[e];
                            if (bj == 0) cg[m][e] = cvv; else cg[m][e] = silu_f(cg[m][e]) * cvv;
                        }
                    }
                }
#pragma unroll
                for (int m = 0; m < 4; ++m) { const int row = u.pm * BM + ai * HALF + wr * 64 + m * 16 + fr;
                    uint2 w; w.x = pk2(cg[m][0], cg[m][1]); w.y = pk2(cg[m][2], cg[m][3]);
                    *(uint2*)(ACT + (size_t)row * DFF + colg) = w; }
            }
        }
    }
};
template <class Epi, class Sched, bool ALIGN_EPI = false, bool SP2 = false>
__device__ __forceinline__ void gemm_phase(PG8_LAS unsigned char* lds, const Gemm g, const Sched& S, const Epi& E) {
    int tid_l = threadIdx.x; asm volatile("" : "+v"(tid_l));
    const int tid = tid_l, wid = __builtin_amdgcn_readfirstlane(tid >> 6), lane = tid & 63, wr = wid >> 2, wc = wid & 3, fr = lane & 15, fq = lane >> 4;
    const int K = g.K, nt = K / BK;
    unsigned voffA[2], voffB[2];
#pragma unroll
    for (int i = 0; i < 2; ++i) { int R, C; stage_rc(tid * 16 + i * 8192, R, C); const int Rb = Epi::PERM ? ((R & ~31) + perm32(R & 31)) : R;
        voffA[i] = (unsigned)(R * K + C) * 2u; voffB[i] = (unsigned)(Rb * K + C) * 2u; }
    const size_t kstep = (size_t)(BK * 2);
    const size_t hstep = (size_t)HALF * K * 2;
    const size_t tstep = 2 * hstep;
    const unsigned ldsw = (unsigned)wid * 1024u;
    const int aoff = lds_byte(wr * 64 + fr, fq * 8), boff = lds_byte(wc * 32 + fr, fq * 8);
#define PG8_SA(b, h) (((b) * 2 + (h)) * HTB)
#define PG8_SB(b, h) ((4 + (b) * 2 + (h)) * HTB)
#define PG8_STAGE(bufoff, gbase, voff) do { _Pragma("unroll") for (int _i = 0; _i < 2; ++_i) \
        __builtin_amdgcn_global_load_lds((const unsigned*)((const char*)(gbase) + (voff)[_i]), (PG8_LAS unsigned*)(lds + (bufoff) + ldsw + _i * 8192), 16, 0, 0); } while (0)
#define PG8_LDA(dst, b, h) do { _Pragma("unroll") for (int m = 0; m < 4; ++m) _Pragma("unroll") for (int k = 0; k < 2; ++k) dst[m][k] = *(const PG8_LAS bf16x8*)(lds + PG8_SA(b, h) + aoff + m * 2048 + k * 1024); } while (0)
#define PG8_LDB(dst, b, h) do { _Pragma("unroll") for (int n = 0; n < 2; ++n) _Pragma("unroll") for (int k = 0; k < 2; ++k) dst[n][k] = *(const PG8_LAS bf16x8*)(lds + PG8_SB(b, h) + boff + n * 2048 + k * 1024); } while (0)
#define PG8_MMA(ai, bj, At, Bt) do { __builtin_amdgcn_s_setprio(1); _Pragma("unroll") for (int m = 0; m < 4; ++m) _Pragma("unroll") for (int n = 0; n < 2; ++n) _Pragma("unroll") for (int k = 0; k < 2; ++k) \
        acc[ai][bj][m][n] = __builtin_amdgcn_mfma_f32_16x16x32_bf16(Bt[n][k], At[m][k], acc[ai][bj][m][n], 0, 0, 0); __builtin_amdgcn_s_setprio(0); } while (0)
#define PG8_WAIT_V(n) asm volatile("s_waitcnt vmcnt(" #n ")" ::: "memory")
#define PG8_WAIT_L(n) asm volatile("s_waitcnt lgkmcnt(" #n ")" ::: "memory")
#define PG8_BAR __builtin_amdgcn_s_barrier()
#define PG8_SCHED __builtin_amdgcn_sched_barrier(0)
    Unit cur, nxt; int ui = 0;
    if (!S.next(0, cur)) return;
    f32x4 acc[2][2][4][2];
#pragma unroll
    for (int a = 0; a < 2; ++a)
#pragma unroll
        for (int b = 0; b < 2; ++b)
#pragma unroll
            for (int m = 0; m < 4; ++m)
#pragma unroll
                for (int n = 0; n < 2; ++n) acc[a][b][m][n] = (f32x4){0.f, 0.f, 0.f, 0.f};
    bf16x8 At[4][2], B0[2][2], B1[2][2];
    const char* cA = (const char*)g.A + (size_t)cur.pm * tstep; const char* cB = (const char*)g.Bt + (size_t)cur.pn * tstep;
    S.a_ready(cur);
    if constexpr (SP2) {
        PG8_STAGE(PG8_SB(0, 0), cB, voffB); PG8_STAGE(PG8_SB(0, 1), cB + hstep, voffB); PG8_STAGE(PG8_SA(0, 0), cA, voffA); PG8_STAGE(PG8_SA(0, 1), cA + hstep, voffA);
        if (wr == 1) PG8_BAR;
        PG8_WAIT_V(2); PG8_BAR;
        PG8_STAGE(PG8_SB(1, 0), cB + kstep, voffB); PG8_STAGE(PG8_SA(1, 0), cA + kstep, voffA); PG8_STAGE(PG8_SB(1, 1), cB + hstep + kstep, voffB);
        PG8_WAIT_V(6); PG8_BAR;
    } else {
        PG8_STAGE(PG8_SB(0, 0), cB, voffB); PG8_STAGE(PG8_SA(0, 0), cA, voffA); PG8_STAGE(PG8_SB(0, 1), cB + hstep, voffB); PG8_STAGE(PG8_SA(0, 1), cA + hstep, voffA);
        if (wr == 1) PG8_BAR;
        PG8_WAIT_V(4); PG8_BAR;
        PG8_STAGE(PG8_SB(1, 0), cB + kstep, voffB); PG8_STAGE(PG8_SA(1, 0), cA + kstep, voffA); PG8_STAGE(PG8_SB(1, 1), cB + hstep + kstep, voffB);
        PG8_WAIT_V(6); PG8_BAR;
    }
    for (;;) {
        const bool has_next = S.next(ui + 1, nxt);
        const char* nA = has_next ? (const char*)g.A + (size_t)nxt.pm * tstep : cA; const char* nB = has_next ? (const char*)g.Bt + (size_t)nxt.pn * tstep : cB;
        for (int t = 0; t < nt; t += 2) {
            const bool last = (t == nt - 2);
            const char* a1 = cA + (size_t)(t + 1) * kstep;
            const char* a2 = last ? nA : cA + (size_t)(t + 2) * kstep; const char* b2 = last ? nB : cB + (size_t)(t + 2) * kstep;
            const char* a3 = a2 + kstep; const char* b3 = b2 + kstep;
            if (last && has_next) S.a_ready(nxt);
            if constexpr (SP2) {
            PG8_LDB(B0, 0, 0); PG8_LDB(B1, 0, 1); PG8_SCHED; PG8_LDA(At, 0, 0); PG8_STAGE(PG8_SA(1, 1), a1 + hstep, voffA);
            PG8_WAIT_V(8); PG8_WAIT_L(0); PG8_BAR; PG8_MMA(0, 0, At, B0); PG8_MMA(0, 1, At, B1); PG8_BAR; PG8_SCHED;
            PG8_LDA(At, 0, 1); PG8_STAGE(PG8_SB(0, 0), b2, voffB); PG8_STAGE(PG8_SB(0, 1), b2 + hstep, voffB); PG8_STAGE(PG8_SA(0, 0), a2, voffA);
            PG8_WAIT_V(8); PG8_WAIT_L(0); PG8_BAR; PG8_MMA(1, 0, At, B0); PG8_MMA(1, 1, At, B1); PG8_BAR; PG8_SCHED;
            PG8_LDB(B0, 1, 0); PG8_LDB(B1, 1, 1); PG8_SCHED; PG8_LDA(At, 1, 0); PG8_STAGE(PG8_SA(0, 1), a2 + hstep, voffA);
            PG8_WAIT_V(8); PG8_WAIT_L(0); PG8_BAR; PG8_MMA(0, 0, At, B0); PG8_MMA(0, 1, At, B1); PG8_BAR; PG8_SCHED;
            PG8_LDA(At, 1, 1); PG8_STAGE(PG8_SB(1, 0), b3, voffB); PG8_STAGE(PG8_SB(1, 1), b3 + hstep, voffB); PG8_STAGE(PG8_SA(1, 0), a3, voffA);
            PG8_WAIT_V(8); PG8_WAIT_L(0); PG8_BAR; PG8_MMA(1, 0, At, B0); PG8_MMA(1, 1, At, B1); PG8_BAR; PG8_SCHED;
            } else {
            PG8_LDB(B0, 0, 0); PG8_SCHED; PG8_LDA(At, 0, 0); PG8_STAGE(PG8_SA(1, 1), a1 + hstep, voffA);
            PG8_WAIT_L(8); PG8_BAR; PG8_WAIT_L(0); PG8_MMA(0, 0, At, B0); PG8_BAR; PG8_SCHED;
            PG8_LDB(B1, 0, 1); PG8_STAGE(PG8_SB(0, 0), b2, voffB);
            PG8_BAR; PG8_WAIT_L(0); PG8_MMA(0, 1, At, B1); PG8_BAR;
            PG8_LDA(At, 0, 1); PG8_STAGE(PG8_SA(0, 0), a2, voffA);
            PG8_BAR; PG8_WAIT_L(0); PG8_MMA(1, 0, At, B0); PG8_BAR; PG8_SCHED;
            PG8_STAGE(PG8_SB(0, 1), b2 + hstep, voffB);
            PG8_WAIT_V(6); PG8_BAR; PG8_MMA(1, 1, At, B1); PG8_BAR;
            PG8_LDB(B0, 1, 0); PG8_SCHED; PG8_LDA(At, 1, 0); PG8_STAGE(PG8_SA(0, 1), a2 + hstep, voffA);
            PG8_WAIT_L(8); PG8_BAR; PG8_WAIT_L(0); PG8_MMA(0, 0, At, B0); PG8_BAR; PG8_SCHED;
            PG8_LDB(B1, 1, 1); PG8_STAGE(PG8_SB(1, 0), b3, voffB);
            PG8_BAR; PG8_WAIT_L(0); PG8_MMA(0, 1, At, B1); PG8_BAR;
            PG8_LDA(At, 1, 1); PG8_STAGE(PG8_SA(1, 0), a3, voffA);
            PG8_BAR; PG8_WAIT_L(0); PG8_MMA(1, 0, At, B0); PG8_BAR; PG8_SCHED;
            PG8_STAGE(PG8_SB(1, 1), b3 + hstep, voffB);
            PG8_WAIT_V(6); PG8_BAR; PG8_MMA(1, 1, At, B1); PG8_BAR;
            }
        }
        if constexpr (ALIGN_EPI) { if (wr == 0) PG8_BAR; }
        if constexpr (!Epi::AFTER_DRAIN) { E(acc, cur, wr, wc, fr, fq, lds); S.done(cur); }
        if (!has_next) break;
#pragma unroll
        for (int a = 0; a < 2; ++a)
#pragma unroll
            for (int b = 0; b < 2; ++b)
#pragma unroll
                for (int m = 0; m < 4; ++m)
#pragma unroll
                    for (int n = 0; n < 2; ++n) acc[a][b][m][n] = (f32x4){0.f, 0.f, 0.f, 0.f};
        cur = nxt; cA = nA; cB = nB; ++ui;
        if constexpr (ALIGN_EPI) { if (wr == 1) PG8_BAR; }
    }
    PG8_WAIT_V(0);
    if constexpr (!ALIGN_EPI) { if (wr == 0) PG8_BAR; }
    PG8_BAR;
    if constexpr (Epi::AFTER_DRAIN) { E.fused(acc, cur, wr, wc, fr, fq, lds, wid, lane); S.done(cur); }
#undef PG8_SA
#undef PG8_SB
#undef PG8_STAGE
#undef PG8_LDA
#undef PG8_LDB
#undef PG8_MMA
#undef PG8_WAIT_V
#undef PG8_WAIT_L
#undef PG8_BAR
#undef PG8_SCHED
}
}
namespace att {
typedef unsigned short bf16_t;
typedef short bf16x8 __attribute__((ext_vector_type(8)));
typedef short s16x4 __attribute__((ext_vector_type(4)));
typedef float f32x16 __attribute__((ext_vector_type(16)));
typedef float f32x4 __attribute__((ext_vector_type(4)));
typedef unsigned u32x4 __attribute__((ext_vector_type(4)));
constexpr int KP = 72;
constexpr int K_BYTES = 2 * 64 * KP * 2;
constexpr int V_BYTES = 2 * 64 * 136 * 2;
constexpr int SC_OFF = K_BYTES + V_BYTES, STASH_OFF = SC_OFF + 1024, ATT_LDS = STASH_OFF + 8 * 8192;
#define MFMA32(a, b, c) __builtin_amdgcn_mfma_f32_32x32x16_bf16((a), (b), (c), 0, 0, 0)
DI s16x4 vtr(const LAS bf16_t* p) { return __builtin_bit_cast(s16x4, __builtin_amdgcn_ds_read_tr16_b64_v4i16((LAS s16x4*)p)); }

template <int MODE>
DI void attn_phase(LAS unsigned char* lds, const bf16_t* __restrict__ QKV, const int ldq, bf16_t* __restrict__ O,
                   const float* lam_p, const float* head_g, const float lam_init, const float* sink, const bool need_ctx, const int vb, const int G) {
    constexpr int DV = MODE == 0 ? 128 : 64, DT = DV / 32, VP = DV + 8, NH = MODE == 0 ? 8 : 16, NPASS = MODE == 0 ? 2 : 1;
    int tid_l = threadIdx.x; asm volatile("" : "+v"(tid_l));
    const int tid = tid_l, lane = tid & 63, r = lane & 31, h = lane >> 5, w = __builtin_amdgcn_readfirstlane(tid >> 6);
    const int i16 = lane & 15, q4 = i16 >> 2, p4 = i16 & 3, blk = (lane >> 4) & 1;
    LAS bf16_t* Ks = (LAS bf16_t*)lds; LAS bf16_t* Vs = (LAS bf16_t*)(lds + K_BYTES);
    LAS float* sc = (LAS float*)(lds + SC_OFF) + w * 32;
    LAS unsigned* stash = (LAS unsigned*)(lds + STASH_OFF) + w * 2048;
    const int lrow = tid >> 3, lch = tid & 7;
    float lam = 0.f;
    if (MODE == 0) { float a = lam_p[lane] * lam_p[64 + lane], b2 = lam_p[128 + lane] * lam_p[192 + lane];
#pragma unroll
        for (int o = 1; o < 64; o <<= 1) { a += __shfl_xor(a, o); b2 += __shfl_xor(b2, o); }
        lam = expf(a) - expf(b2) + lam_init; }
    const int NLAT = NBATCH * NH * 8, NU = NLAT + (need_ctx ? NBATCH * NH : 0);
#pragma unroll 1
    for (int u = vb; u < NU; u += G) {
        int b, hd, qb; bool isctx = u >= NLAT;
        if (!isctx) { qb = u & 7; hd = (u >> 3) % NH; b = u / (8 * NH); } else { const int v = u - NLAT; qb = 0; hd = v % NH; b = v / NH; }
        const int qrow0 = isctx ? MLAT + b * CTXL : b * SEQL + 256 * qb;
        int t0 = 0, nl = 0;
        if (!isctx) { if (MODE == 2) { t0 = 4 * qb - 2 < 0 ? 0 : 4 * qb - 2; const int t1 = 4 * qb + 5 > 31 ? 31 : 4 * qb + 5; nl = t1 - t0 + 1; } else { nl = 32; } }
        const int nt = nl + 4;
        const int qw = 256 * qb + 32 * w;
        f32x16 o[DT];
#pragma unroll 1
        for (int pass = 0; pass < NPASS; ++pass) {
            const int qcol = MODE == 0 ? hd * 128 + pass * 64 : hd * 64;
            const int kcol = MODE == 0 ? 1024 + hd * 128 + pass * 64 : 1024 + (hd >> 2) * 64;
            const int vcol = MODE == 0 ? 2048 + hd * 128 : 1280 + (hd >> 2) * 64;
            bf16x8 qf[4];
            { const bf16_t* qp = QKV + (size_t)(qrow0 + 32 * w + r) * ldq + qcol + 8 * h;
#pragma unroll
              for (int s = 0; s < 4; ++s) qf[s] = *(const bf16x8*)(qp + 16 * s); }
            float m = -1e30f, lsum = 0.f;
#pragma unroll
            for (int dt = 0; dt < DT; ++dt)
#pragma unroll
                for (int i = 0; i < 16; ++i) o[dt][i] = 0.f;
            __syncthreads();
            u32x4 kreg, vreg[DT / 2];
            { const int krow = nl > 0 ? b * SEQL + 64 * t0 : MLAT + b * CTXL;
              const bf16_t* gp = QKV + (size_t)(krow + lrow) * ldq;
              kreg = *(const u32x4*)(gp + kcol + 8 * lch);
#pragma unroll
              for (int j = 0; j < DT / 2; ++j) vreg[j] = *(const u32x4*)(gp + vcol + 8 * lch + 64 * j); }
#pragma unroll 1
            for (int t = 0; t < nt; ++t) {
                const int buf = t & 1;
                *(LAS u32x4*)(Ks + (buf * 64 + lrow) * KP + 8 * lch) = kreg;
#pragma unroll
                for (int j = 0; j < DT / 2; ++j) *(LAS u32x4*)(Vs + (buf * 64 + lrow) * VP + 8 * lch + 64 * j) = vreg[j];
                __syncthreads();
                if (t + 1 < nt) { const int tn = t + 1; const int krow = tn < nl ? b * SEQL + 64 * (t0 + tn) : MLAT + b * CTXL + 64 * (tn - nl);
                    const bf16_t* gp = QKV + (size_t)(krow + lrow) * ldq;
                    kreg = *(const u32x4*)(gp + kcol + 8 * lch);
#pragma unroll
                    for (int j = 0; j < DT / 2; ++j) vreg[j] = *(const u32x4*)(gp + vcol + 8 * lch + 64 * j); }
                const bool lat_tile = t < nl; const int kpos0 = 64 * (t0 + t);
                bool skip = false, domask = false;
                if (MODE == 2 && lat_tile) { skip = (kpos0 > qw + 31 + 128) || (kpos0 + 63 < qw - 128); domask = !((kpos0 + 63 <= qw + 128) && (kpos0 >= qw + 31 - 128)); }
                if (!skip) {
                    const LAS bf16_t* Kt = Ks + buf * 64 * KP; const LAS bf16_t* Vt = Vs + buf * 64 * VP;
                    f32x16 p0, p1;
#pragma unroll
                    for (int i = 0; i < 16; ++i) { p0[i] = 0.f; p1[i] = 0.f; }
#pragma unroll
                    for (int s = 0; s < 4; ++s) {
                        const bf16x8 ka = *(const LAS bf16x8*)(Kt + r * KP + 16 * s + 8 * h);
                        const bf16x8 kb = *(const LAS bf16x8*)(Kt + (32 + r) * KP + 16 * s + 8 * h);
                        p0 = MFMA32(ka, qf[s], p0); p1 = MFMA32(kb, qf[s], p1);
                    }
                    if (MODE == 2 && domask) { const int qpos = qw + r;
#pragma unroll
                        for (int i = 0; i < 16; ++i) { const int d0 = kpos0 + (i & 3) + 8 * (i >> 2) + 4 * h - qpos;
                            if (d0 > 128 || d0 < -128) p0[i] = -INFINITY;
                            if (d0 + 32 > 128 || d0 + 32 < -128) p1[i] = -INFINITY; } }
                    float mt = fmaxf(p0[0], p1[0]);
#pragma unroll
                    for (int i = 1; i < 16; ++i) mt = fmaxf(mt, fmaxf(p0[i], p1[i]));
                    mt = fmaxf(mt, __shfl_xor(mt, 32));
                    const float mnew = fmaxf(m, mt);
                    if (__any(mnew > m)) {
                        const float alpha = __builtin_amdgcn_exp2f(m - mnew);
                        lsum *= alpha;
                        if (h == 0) sc[r] = alpha;
                        asm volatile("s_waitcnt lgkmcnt(0)" ::: "memory");
#pragma unroll
                        for (int g = 0; g < 4; ++g) { const f32x4 a4 = *(const LAS f32x4*)(sc + 8 * g + 4 * h);
#pragma unroll
                            for (int dt = 0; dt < DT; ++dt)
#pragma unroll
                                for (int j = 0; j < 4; ++j) o[dt][4 * g + j] *= a4[j]; }
                        asm volatile("s_waitcnt lgkmcnt(0)" ::: "memory");
                    }
                    m = mnew;
                    float ps = 0.f;
#pragma unroll
                    for (int i = 0; i < 16; ++i) { p0[i] = __builtin_amdgcn_exp2f(p0[i] - mnew); p1[i] = __builtin_amdgcn_exp2f(p1[i] - mnew); ps += p0[i] + p1[i]; }
                    lsum += ps;
                    bf16x8 pf[4];
#pragma unroll
                    for (int ks = 0; ks < 4; ++ks) { u32x4 wv;
#pragma unroll
                        for (int j = 0; j < 4; ++j) { const int i0 = 8 * (ks & 1) + 2 * j; wv[j] = ks < 2 ? pk2(p0[i0], p0[i0 + 1]) : pk2(p1[i0], p1[i0 + 1]); }
                        pf[ks] = __builtin_bit_cast(bf16x8, wv); }
#pragma unroll
                    for (int ks = 0; ks < 4; ++ks)
#pragma unroll
                        for (int dt = 0; dt < DT; ++dt) {
                            const LAS bf16_t* vp = Vt + (16 * ks + 4 * h + q4) * VP + 32 * dt + 16 * blk + 4 * p4;
                            const s16x4 lo = vtr(vp), hi = vtr(vp + 8 * VP);
                            const bf16x8 vf = __builtin_shufflevector(lo, hi, 0, 1, 2, 3, 4, 5, 6, 7);
                            o[dt] = MFMA32(pf[ks], vf, o[dt]);
                        }
                }
            }
            float lt = lsum + __shfl_xor(lsum, 32);
            if (MODE == 2) lt += __builtin_amdgcn_exp2f(sink[hd] * 1.4426950408889634f - m);
            const float inv = 1.f / lt;
            if (h == 0) sc[r] = inv;
            asm volatile("s_waitcnt lgkmcnt(0)" ::: "memory");
#pragma unroll
            for (int g = 0; g < 4; ++g) { const f32x4 a4 = *(const LAS f32x4*)(sc + 8 * g + 4 * h);
#pragma unroll
                for (int dt = 0; dt < DT; ++dt)
#pragma unroll
                    for (int j = 0; j < 4; ++j) o[dt][4 * g + j] *= a4[j]; }
            asm volatile("s_waitcnt lgkmcnt(0)" ::: "memory");
            if (MODE == 0 && pass == 0) {
#pragma unroll
                for (int dt = 0; dt < DT; ++dt)
#pragma unroll
                    for (int j = 0; j < 8; ++j) stash[(dt * 8 + j) * 64 + lane] = pk2(o[dt][2 * j], o[dt][2 * j + 1]);
            }
        }
        if (MODE == 0) {
            float ssq[16];
#pragma unroll
            for (int i = 0; i < 16; ++i) ssq[i] = 0.f;
#pragma unroll
            for (int dt = 0; dt < DT; ++dt)
#pragma unroll
                for (int j = 0; j < 8; ++j) { const unsigned pk = stash[(dt * 8 + j) * 64 + lane];
                    const float a0 = bf_lo(pk) - lam * o[dt][2 * j], a1 = bf_hi(pk) - lam * o[dt][2 * j + 1];
                    o[dt][2 * j] = a0; o[dt][2 * j + 1] = a1; ssq[2 * j] += a0 * a0; ssq[2 * j + 1] += a1 * a1; }
#pragma unroll
            for (int i = 0; i < 16; ++i) {
#pragma unroll
                for (int off = 1; off < 32; off <<= 1) ssq[i] += __shfl_xor(ssq[i], off);
                ssq[i] = __builtin_amdgcn_rsqf(ssq[i] * (1.f / 128.f) + EPSN) * (1.f - lam_init); }
#pragma unroll
            for (int dt = 0; dt < DT; ++dt) { const float hg = head_g[32 * dt + r];
#pragma unroll
                for (int i = 0; i < 16; ++i) o[dt][i] *= ssq[i] * hg; }
        }
        { bf16_t* op = O + (size_t)(qrow0 + 32 * w) * DM + hd * DV + r;
#pragma unroll
          for (int dt = 0; dt < DT; ++dt)
#pragma unroll
              for (int i = 0; i < 16; ++i) { const int row = (i & 3) + 8 * (i >> 2) + 4 * h; op[(size_t)row * DM + 32 * dt] = (bf16_t)(pk2(o[dt][i], 0.f) & 0xffffu); } }
    }
}
#undef MFMA32
}
typedef unsigned short bf16;
typedef float f32x4 __attribute__((ext_vector_type(4)));
typedef unsigned v4u __attribute__((ext_vector_type(4)));
constexpr int NWAVES = 8, NTHREADS = 512;
constexpr size_t MiB = 1u << 20;
constexpr size_t WS_MOD = 0, WS_ROPE = 2 * MiB, WS_HB = 3 * MiB, WS_WQKV = 16 * MiB, WS_WO = 22 * MiB, WS_WUP = 24 * MiB, WS_WDN = 35 * MiB,
                 WS_X = 41 * MiB, WS_HN = 185 * MiB, WS_QKV = 257 * MiB, WS_END = 473 * MiB;
static_assert((size_t)DEPTH * NMODB * MODW * 4 <= 2 * MiB && (size_t)144 * 4 * NUP * 4 <= 13 * MiB && (size_t)NUP * DM * 2 <= 11 * MiB && (size_t)DM * DFF * 2 <= 6 * MiB, "ws map");
static_assert((size_t)MTOT * DM * 4 == 144 * MiB && (size_t)MTOT * DM * 2 == 72 * MiB && (size_t)MTOT * 3072 * 2 == 216 * MiB && (size_t)MTOT * DFF * 2 <= 216 * MiB, "ws map 2");
constexpr int LDS_BYTES = 147456;

#ifndef PHM
#define PHM 0xffff
#endif
struct Args {
    const float *x, *c, *ctx, *c_ctx, *adaln_w, *adaln_b, *norm1_g, *norm2_g, *ffn_w_up, *ffn_conv_w, *ffn_conv_b, *ffn_w_down,
                *a_w_qkv, *a_qk_g, *a_lambda, *a_head_g, *a_w_o, *b_w_qkv, *b_qk_g, *b_w_o, *c_w_qkv, *c_qk_g, *c_sink, *c_w_o;
    float* out; unsigned char* ws;
};

DI float wave_sum(float v) {
#pragma unroll
    for (int o = 1; o < 64; o <<= 1) v += __shfl_xor(v, o);
    return v;
}
DI void transpose_item(const float* W, int K, int N, bf16* WT, int k0, int n0, int dst_row0, LAS float* scr, int lane) {
#pragma unroll 8
    for (int i = 0; i < 32; ++i) { const int kk = 2 * i + (lane >> 5); scr[kk * 33 + (lane & 31)] = W[(size_t)(k0 + kk) * N + n0 + (lane & 31)]; }
    asm volatile("s_waitcnt lgkmcnt(0)" ::: "memory");
    const int c = lane & 7;
#pragma unroll
    for (int j = 0; j < 4; ++j) { const int n = (lane >> 3) + 8 * j; const LAS float* s = scr + (8 * c) * 33 + n;
        v4u o; o.x = pk2(s[0 * 33], s[1 * 33]); o.y = pk2(s[2 * 33], s[3 * 33]); o.z = pk2(s[4 * 33], s[5 * 33]); o.w = pk2(s[6 * 33], s[7 * 33]);
        *(v4u*)(WT + (size_t)(dst_row0 + n) * K + k0 + 8 * c) = o; }
    asm volatile("s_waitcnt lgkmcnt(0)" ::: "memory");
}
DI void convert_weights(const Args& a, int layer, LAS unsigned char* lds, int gw, int NGW, int wave, int lane) {
    LAS float* scr = (LAS float*)(lds + wave * 16384);
    const int kind = layer % 3, j = layer / 3;
    const int NQ = kind == 0 ? 3072 : 1536;
    const float* wqkv = kind == 0 ? a.a_w_qkv + (size_t)j * DM * 3072 : (kind == 1 ? a.b_w_qkv : a.c_w_qkv) + (size_t)j * DM * 1536;
    const float* wo = (kind == 0 ? a.a_w_o : (kind == 1 ? a.b_w_o : a.c_w_o)) + (size_t)j * DM * DM;
    const float* wup = a.ffn_w_up + (size_t)layer * DM * NUP;
    const float* wdn = a.ffn_w_down + (size_t)layer * DFF * DM;
    bf16* Wqkv_t = (bf16*)(a.ws + WS_WQKV); bf16* Wo_t = (bf16*)(a.ws + WS_WO); bf16* Wup_t = (bf16*)(a.ws + WS_WUP); bf16* Wdn_t = (bf16*)(a.ws + WS_WDN);
    const int I_Q = (DM / 64) * (NQ / 32), I_O = (DM / 64) * (DM / 32), I_U = (DM / 64) * (NUP / 32), I_D = (DFF / 64) * (DM / 32);
    for (int it = gw; it < I_Q + I_O + I_U + I_D; it += NGW) {
        int r = it;
        if (r < I_Q) { const int nb = r % (NQ / 32), kb = r / (NQ / 32), tile = nb >> 3, bc = nb & 7;
            transpose_item(wqkv, DM, NQ, Wqkv_t, 64 * kb, 32 * nb, 256 * tile + 32 * (4 * (bc & 1) + (bc >> 1)), scr, lane); continue; }
        r -= I_Q;
        if (r < I_O) { const int nb = r % (DM / 32), kb = r / (DM / 32); transpose_item(wo, DM, DM, Wo_t, 64 * kb, 32 * nb, 32 * nb, scr, lane); continue; }
        r -= I_O;
        if (r < I_U) { const int nb = r % (NUP / 32), kb = r / (NUP / 32); const int n0 = 32 * nb, bj = n0 >= DFF ? 1 : 0, ch = n0 - bj * DFF;
            transpose_item(wup, DM, NUP, Wup_t, 64 * kb, n0, 256 * (ch >> 7) + 128 * bj + (ch & 127), scr, lane); continue; }
        r -= I_U;
        { const int nb = r % (DM / 32), kb = r / (DM / 32); transpose_item(wdn, DFF, DM, Wdn_t, 64 * kb, 32 * nb, 32 * nb, scr, lane); }
    }
}
DI void prologue(const Args& a, LAS unsigned char* lds, int tid, int wave, int lane, int G) {
    float* MOD = (float*)(a.ws + WS_MOD);
    LAS float* scl = (LAS float*)lds;
    LAS float* red = (LAS float*)(lds + 17 * 1024 * 4);
    for (int idx = tid; idx < NMODB * DM; idx += NTHREADS) { const int bb = idx >> 10, k = idx & 1023; const float v = bb < NBATCH ? a.c[bb * DM + k] : a.c_ctx[k]; scl[idx] = v / (1.f + expf(-v)); }
    __syncthreads();
#pragma unroll 1
    for (int task = blockIdx.x; task < DEPTH * (MODW / 64); task += G) {
        const int layer = task / (MODW / 64), n0 = (task % (MODW / 64)) * 64;
        const float* W = a.adaln_w + (size_t)layer * DM * MODW + n0 + lane;
        float acc[NMODB];
#pragma unroll
        for (int bb = 0; bb < NMODB; ++bb) acc[bb] = 0.f;
#pragma unroll 4
        for (int kk = 0; kk < 128; ++kk) { const int k = 128 * wave + kk; const float wv = W[(size_t)k * MODW];
#pragma unroll
            for (int bb = 0; bb < NMODB; ++bb) acc[bb] += scl[bb * DM + k] * wv; }
#pragma unroll
        for (int bb = 0; bb < NMODB; ++bb) red[(wave * NMODB + bb) * 64 + lane] = acc[bb];
        __syncthreads();
        for (int o = tid; o < NMODB * 64; o += NTHREADS) { const int bb = o >> 6, ln = o & 63; float s = a.adaln_b[layer * MODW + n0 + ln];
#pragma unroll
            for (int w8 = 0; w8 < 8; ++w8) s += red[(w8 * NMODB + bb) * 64 + ln];
            MOD[((size_t)layer * NMODB + bb) * MODW + n0 + ln] = s; }
        __syncthreads();
    }
    float* rcos = (float*)(a.ws + WS_ROPE); float* rsin = rcos + SEQL * 32;
    for (int idx = blockIdx.x * NTHREADS + tid; idx < SEQL * 32; idx += G * NTHREADS) { const int t = idx >> 5, jj = idx & 31, f = jj & 15; const float pos = (float)(jj < 16 ? (t >> 6) : (t & 63));
        const float inv = exp2f(-(float)f * (13.287712379549449f / 16.f)); const float ang = pos * inv; rcos[idx] = cosf(ang); rsin[idx] = sinf(ang); }
    __syncthreads();
    convert_weights(a, 0, lds, blockIdx.x * NWAVES + wave, G * NWAVES, wave, lane);
}
DI void norm_pass(const Args& a, int layer, int which, int nrows, int gw, int NGW, int lane) {
    const float* MOD = (const float*)(a.ws + WS_MOD) + (size_t)layer * NMODB * MODW;
    const float* X = (const float*)(a.ws + WS_X); bf16* HN = (bf16*)(a.ws + WS_HN);
    const float* g = (which == 1 ? a.norm1_g : a.norm2_g) + layer * DM;
    const int sh_off = which == 1 ? 0 : 3 * DM, sc_off = which == 1 ? DM : 4 * DM;
    const bool from_input = (layer == 0 && which == 1);
    for (int row = gw; row < nrows; row += NGW) {
        const float* src = from_input ? (row < MLAT ? a.x + (size_t)row * DM : a.ctx + (size_t)(row - MLAT) * DM) : X + (size_t)row * DM;
        const int bb = row < MLAT ? row >> 11 : NBATCH;
        const f32x4* xr = (const f32x4*)src + lane; f32x4 v[4]; float s = 0.f;
#pragma unroll
        for (int j = 0; j < 4; ++j) { v[j] = xr[64 * j]; s += (v[j].x * v[j].x + v[j].y * v[j].y) + (v[j].z * v[j].z + v[j].w * v[j].w); }
        const float rstd = 1.f / sqrtf(wave_sum(s) * (1.f / DM) + EPSN);
        const f32x4* g4 = (const f32x4*)g + lane; const f32x4* sc4 = (const f32x4*)(MOD + (size_t)bb * MODW + sc_off) + lane; const f32x4* sh4 = (const f32x4*)(MOD + (size_t)bb * MODW + sh_off) + lane;
        uint2* o8 = (uint2*)(HN + (size_t)row * DM) + lane;
#pragma unroll
        for (int j = 0; j < 4; ++j) { const f32x4 y = v[j] * rstd * g4[64 * j] * (sc4[64 * j] + 1.f) + sh4[64 * j]; uint2 w; w.x = pk2(y.x, y.y); w.y = pk2(y.z, y.w); o8[64 * j] = w; }
    }
}
DI void conv_fixup(const Args& a, int layer, int ntiles, int gt, int GT) {
    const float* HB = (const float*)(a.ws + WS_HB); bf16* ACT = (bf16*)(a.ws + WS_QKV);
    const float* cw = a.ffn_conv_w + (size_t)layer * 3 * NUP; const float* cb = a.ffn_conv_b + (size_t)layer * NUP;
    for (int idx = gt; idx < ntiles * 2 * (DFF / 4); idx += GT) {
        const int ch = (idx % (DFF / 4)) * 4, pe = idx / (DFF / 4), edge = pe & 1, pm = pe >> 1;
        const bool lat = pm < MLAT / 256; const bool start = lat ? (pm & 7) == 0 : true, end = lat ? (pm & 7) == 7 : true;
        const float* hb = HB + (size_t)pm * 4 * NUP;
        f32x4 cv[2];
#pragma unroll
        for (int hf = 0; hf < 2; ++hf) { const int col = hf * DFF + ch; f32x4 up, uc, un; const f32x4 z = (f32x4){0.f, 0.f, 0.f, 0.f};
            if (edge == 0) { up = start ? z : *(const f32x4*)(hb - NUP + col); uc = *(const f32x4*)(hb + col); un = *(const f32x4*)(hb + NUP + col); }
            else { up = *(const f32x4*)(hb + 2 * NUP + col); uc = *(const f32x4*)(hb + 3 * NUP + col); un = end ? z : *(const f32x4*)(hb + 4 * NUP + col); }
            cv[hf] = *(const f32x4*)(cw + col) * up + *(const f32x4*)(cw + NUP + col) * uc + *(const f32x4*)(cw + 2 * NUP + col) * un + *(const f32x4*)(cb + col); }
        uint2 w; w.x = pk2(silu_f(cv[0].x) * cv[1].x, silu_f(cv[0].y) * cv[1].y); w.y = pk2(silu_f(cv[0].z) * cv[1].z, silu_f(cv[0].w) * cv[1].w);
        *(uint2*)(ACT + (size_t)(256 * pm + (edge ? 255 : 0)) * DFF + ch) = w;
    }
}

__global__ void __launch_bounds__(NTHREADS, 2) fwd_mega(Args a) {
    extern __shared__ __attribute__((aligned(16))) unsigned char lds_raw[];
    LAS unsigned char* lds = (LAS unsigned char*)lds_raw;
    cg::grid_group grid = cg::this_grid();
    const int G = gridDim.x, bx = blockIdx.x;
    const int vb = (G % 8 == 0) ? (bx % 8) * (G / 8) + bx / 8 : bx;
    const int NGW = G * NWAVES, GT = G * NTHREADS;
#define PHASE_IDS() int tid = threadIdx.x; asm volatile("" : "+v"(tid)); const int lane = tid & 63, wave = __builtin_amdgcn_readfirstlane(tid >> 6), gw = bx * NWAVES + wave, gt = bx * NTHREADS + tid; (void)lane; (void)wave; (void)gw; (void)gt
    float* MODp = (float*)(a.ws + WS_MOD); const float* rcos = (const float*)(a.ws + WS_ROPE); const float* rsin = rcos + SEQL * 32;
    float* X = (float*)(a.ws + WS_X); bf16* HN = (bf16*)(a.ws + WS_HN); bf16* QKV = (bf16*)(a.ws + WS_QKV); bf16* ACT = QKV; float* HB = (float*)(a.ws + WS_HB);
    bf16* Wqkv_t = (bf16*)(a.ws + WS_WQKV); bf16* Wo_t = (bf16*)(a.ws + WS_WO); bf16* Wup_t = (bf16*)(a.ws + WS_WUP); bf16* Wdn_t = (bf16*)(a.ws + WS_WDN);

    if (PHM & 1) { PHASE_IDS(); prologue(a, lds, tid, wave, lane, G); }
    grid.sync();
#pragma unroll 1
    for (int layer = 0; layer < DEPTH; ++layer) {
        const int kind = layer % 3, j = layer / 3; const bool last = layer == DEPTH - 1;
        const int NQ = kind == 0 ? 3072 : 1536, MR = last ? MLAT : MTOT;
        const float* MODl = MODp + (size_t)layer * NMODB * MODW;
        if (PHM & 2) { PHASE_IDS(); if (layer > 0) { __syncthreads(); convert_weights(a, layer, lds, gw, NGW, wave, lane); }
            norm_pass(a, layer, 1, MTOT, gw, NGW, lane); }
        grid.sync();
        if (PHM & 4) { pg8::Gemm g{HN, Wqkv_t, MTOT, NQ, DM}; pg8::StaticOrder S; S.init(MTOT, NQ, G, bx);
          const float* qkg = (kind == 0 ? a.a_qk_g : (kind == 1 ? a.b_qk_g : a.c_qk_g)) + j * 128;
          pg8::EpiQKV E{QKV, NQ, qkg, qkg + 64, rcos, rsin, 4, kind == 0 ? 4 : 1};
          pg8::gemm_phase<pg8::EpiQKV, pg8::StaticOrder, true, true>(lds, g, S, E); }
        grid.sync();
        if (!(PHM & 8)) {} else if (kind == 0) att::attn_phase<0>(lds, QKV, NQ, HN, a.a_lambda + j * 256, a.a_head_g + j * 128, 0.8f - 0.6f * expf(-0.3f * (float)layer), nullptr, !last, vb, G);
        else if (kind == 1 && (PHM & 16)) att::attn_phase<1>(lds, QKV, NQ, HN, nullptr, nullptr, 0.f, nullptr, !last, vb, G);
        else if (PHM & 32) att::attn_phase<2>(lds, QKV, NQ, HN, nullptr, nullptr, 0.f, a.c_sink + j * 16, !last, vb, G);
        grid.sync();
        if (PHM & 64) { pg8::Gemm g{HN, Wo_t, MR, DM, DM}; pg8::StaticOrder S; S.init(MR, DM, G, bx);
          pg8::EpiResid E{layer == 0 ? a.x : X, layer == 0 ? a.ctx - (size_t)MLAT * DM : X, X, MODl + 2 * DM};
          pg8::gemm_phase<pg8::EpiResid, pg8::StaticOrder, true, true>(lds, g, S, E); }
        grid.sync();
        if (PHM & 128) { PHASE_IDS(); norm_pass(a, layer, 2, MR, gw, NGW, lane); }
        grid.sync();
        if (PHM & 256) { pg8::Gemm g{HN, Wup_t, MR, NUP, DM}; pg8::StaticOrder S; S.init(MR, NUP, G, bx);
          pg8::EpiConv E{ACT, HB, a.ffn_conv_w + (size_t)layer * 3 * NUP, a.ffn_conv_b + (size_t)layer * NUP};
          pg8::gemm_phase<pg8::EpiConv, pg8::StaticOrder, true, true>(lds, g, S, E); }
        grid.sync();
        if (PHM & 512) { PHASE_IDS(); conv_fixup(a, layer, MR / 256, gt, GT); }
        grid.sync();
        if (PHM & 1024) { pg8::Gemm g{ACT, Wdn_t, MR, DM, DFF}; pg8::StaticOrder S; S.init(MR, DM, G, bx);
          pg8::EpiResid E{X, X, last ? a.out : X, MODl + 5 * DM};
          pg8::gemm_phase<pg8::EpiResid, pg8::StaticOrder, true, true>(lds, g, S, E); }
        if (!last) grid.sync();
    }
}

extern "C" void kernel_launch(void* const* d_in, const int* in_sizes, int n_in, void* d_out, int out_size, void* d_ws, size_t ws_size, hipStream_t stream) {
    static int grid = 0;
    if (grid == 0) {
        int dev = 0, cus = 0, per_cu = 0;
        if (n_in != 24 || out_size != MLAT * DM || ws_size < WS_END) { fprintf(stderr, "kernel_launch: unexpected shapes n_in %d out %d ws %zu\n", n_in, out_size, ws_size); grid = -1; return; }
        (void)hipGetDevice(&dev); (void)hipDeviceGetAttribute(&cus, hipDeviceAttributeMultiprocessorCount, dev);
        (void)hipFuncSetAttribute((const void*)fwd_mega, hipFuncAttributeMaxDynamicSharedMemorySize, LDS_BYTES);
        (void)hipOccupancyMaxActiveBlocksPerMultiprocessor(&per_cu, (const void*)fwd_mega, NTHREADS, LDS_BYTES);
        if (per_cu < 1) per_cu = 1;
        grid = cus * per_cu;
        fprintf(stderr, "kernel_launch: cus %d per_cu %d grid %d ws %zu\n", cus, per_cu, grid, ws_size);
    }
    if (grid < 0) return;
    Args a{};
    const float** ap = (const float**)&a;
    for (int i = 0; i < 24; ++i) ap[i] = (const float*)d_in[i];
    a.out = (float*)d_out; a.ws = (unsigned char*)d_ws;
    void* args[] = {&a};
    hipError_t e = hipLaunchCooperativeKernel((const void*)fwd_mega, dim3(grid), dim3(NTHREADS), args, LDS_BYTES, stream);
    if (e != hipSuccess) fprintf(stderr, "cooperative launch failed: %s (grid %d)\n", hipGetErrorString(e), grid);
}
```

```cpp
#include <hip/hip_runtime.h>
#include <hip/hip_cooperative_groups.h>
#include <cstdio>
#include <cstdint>
namespace cg = cooperative_groups;
#define LAS __attribute__((address_space(3)))
#define DI __device__ __forceinline__
constexpr int DM = 1024, NBATCH = 16, SEQL = 2048, CTXL = 256, DEPTH = 4;
constexpr int MLAT = NBATCH * SEQL, MCTX = NBATCH * CTXL, MTOT = MLAT + MCTX;
constexpr int DFF = 2816, NUP = 2 * DFF, MODW = 6 * DM, NMODB = NBATCH + 1;
constexpr float EPSN = 1e-6f;
constexpr float QSCALE = 0.125f * 1.4426950408889634f;
typedef float f32x2_t __attribute__((ext_vector_type(2)));
typedef __bf16 bf16x2_t __attribute__((ext_vector_type(2)));
DI unsigned pk2(float lo, float hi) { f32x2_t v = {lo, hi}; bf16x2_t b = __builtin_convertvector(v, bf16x2_t); return __builtin_bit_cast(unsigned, b); }
DI float bf_lo(unsigned u) { return __uint_as_float(u << 16); }
DI float bf_hi(unsigned u) { return __uint_as_float(u & 0xffff0000u); }
DI float silu_f(float g) { return g * __builtin_amdgcn_rcpf(1.f + __builtin_amdgcn_exp2f(-1.4426950408889634f * g)); }
DI int lane_id_opaque() { int l; asm volatile("v_mbcnt_lo_u32_b32 %0, -1, 0\n\tv_mbcnt_hi_u32_b32 %0, -1, %0" : "=v"(l)); return l; }
namespace pg8 {
#define PG8_LAS __attribute__((address_space(3)))
typedef unsigned short bf16_t;
typedef short bf16x8 __attribute__((ext_vector_type(8)));
typedef float f32x4 __attribute__((ext_vector_type(4)));
typedef unsigned u32x4 __attribute__((ext_vector_type(4)));
constexpr int BM = 256, BK = 64, HALF = 128, HTB = HALF * BK * 2  , STAGE_BYTES = 8 * HTB, NXCD = 8, WGM = 8;

__host__ __device__ __forceinline__ int lds_byte(int r, int c) { const int st = (r >> 4) * 2 + (c >> 5), rr = r & 15, cc = c & 31, ob = rr * 64 + cc * 2; return st * 1024 + (ob ^ (((ob >> 9) & 1) << 5)); }
__host__ __device__ __forceinline__ void stage_rc(int b, int& R, int& C) { const int st = b / 1024, sb = b % 1024, swz = sb ^ (((sb >> 9) & 1) << 5); R = (st >> 1) * 16 + swz / 64; C = (st & 1) * 32 + (swz % 64) / 2; }
__host__ __device__ __forceinline__ int perm32(int rho) { const int n = rho >> 4, i = rho & 15; return 8 * (i >> 2) + 4 * n + (i & 3); }

struct Unit { int pm, pn; };
struct Gemm { const bf16_t* A; const bf16_t* Bt; int M, N, K; };

struct StaticOrder {
    int nM, nN, nwg, G, c;
    __host__ __device__ void init(int M, int N, int G_, int c_) { nM = M / BM; nN = N / BM; nwg = nM * nN; G = G_; c = c_; }
    __host__ __device__ bool next(int i, Unit& u) const {
        const long L = (long)i * G + c; if (L >= nwg) return false;
        int wgid = (int)L; { const int q = nwg / NXCD, r = nwg % NXCD, xcd = wgid % NXCD, off = wgid / NXCD; wgid = (xcd < r ? xcd * (q + 1) : r * (q + 1) + (xcd - r) * q) + off; }
        const int nig = WGM * nN, gid = wgid / nig, fm = gid * WGM, gsz = (nM - fm) < WGM ? (nM - fm) : WGM;
        u.pm = fm + ((wgid % nig) % gsz); u.pn = (wgid % nig) / gsz; return true;
    }
    __device__ __forceinline__ void a_ready(const Unit&) const {}
    __device__ __forceinline__ void done(const Unit&) const {}
};

struct EpiQKV {
    static constexpr bool PERM = true, AFTER_DRAIN = false;
    bf16_t* O; int ldc; const float* qg; const float* kg; const float* rcos; const float* rsin; int nq_tiles, nk_tiles;
    __device__ __forceinline__ void operator()(const f32x4 (&acc)[2][2][4][2], const Unit& u, int wr, int wc, int fr, int fq, PG8_LAS unsigned char*) const {
        const int kind = u.pn < nq_tiles ? 0 : (u.pn < nq_tiles + nk_tiles ? 1 : 2);
        const int col0 = u.pn * BM + 64 * wc + 8 * fq;
        if (kind == 2) {
#pragma unroll
            for (int ai = 0; ai < 2; ++ai)
#pragma unroll
                for (int m = 0; m < 4; ++m) { bf16_t* rowp = O + (size_t)(u.pm * BM + ai * HALF + wr * 64 + m * 16 + fr) * ldc + col0;
#pragma unroll
                    for (int bj = 0; bj < 2; ++bj) { const f32x4 v0 = acc[ai][bj][m][0], v1 = acc[ai][bj][m][1]; u32x4 w; w.x = pk2(v0[0], v0[1]); w.y = pk2(v0[2], v0[3]); w.z = pk2(v1[0], v1[1]); w.w = pk2(v1[2], v1[3]);
                        *(u32x4*)(rowp + 32 * bj) = w; } }
            return;
        }
        const float* g = kind == 0 ? qg : kg; const float qs = kind == 0 ? QSCALE : 1.f;
        f32x4 g0[2], g1[2];
#pragma unroll
        for (int n = 0; n < 2; ++n) { g0[n] = *(const f32x4*)(g + 8 * fq + 4 * n); g1[n] = *(const f32x4*)(g + 32 + 8 * fq + 4 * n); }
#pragma unroll
        for (int ai = 0; ai < 2; ++ai)
#pragma unroll
            for (int m = 0; m < 4; ++m) {
                const int row = u.pm * BM + ai * HALF + wr * 64 + m * 16 + fr;
                float ss = 0.f;
#pragma unroll
                for (int bj = 0; bj < 2; ++bj)
#pragma unroll
                    for (int n = 0; n < 2; ++n) { const f32x4 x = acc[ai][bj][m][n]; ss += (x[0] * x[0] + x[1] * x[1]) + (x[2] * x[2] + x[3] * x[3]); }
                ss += __shfl_xor(ss, 16); ss += __shfl_xor(ss, 32);
                const float rstd = __builtin_amdgcn_rsqf(ss * (1.f / 64.f) + EPSN) * qs;
                f32x4 cs[2], sn[2];
                if (row < MLAT) { const int t = row & (SEQL - 1);
#pragma unroll
                    for (int n = 0; n < 2; ++n) { cs[n] = *(const f32x4*)(rcos + t * 32 + 8 * fq + 4 * n); sn[n] = *(const f32x4*)(rsin + t * 32 + 8 * fq + 4 * n); } }
                else { cs[0] = cs[1] = (f32x4){1.f, 1.f, 1.f, 1.f}; sn[0] = sn[1] = (f32x4){0.f, 0.f, 0.f, 0.f}; }
                f32x4 o1[2], o2[2];
#pragma unroll
                for (int n = 0; n < 2; ++n) { const f32x4 y1 = acc[ai][0][m][n] * rstd * g0[n], y2 = acc[ai][1][m][n] * rstd * g1[n]; o1[n] = y1 * cs[n] - y2 * sn[n]; o2[n] = y2 * cs[n] + y1 * sn[n]; }
                bf16_t* rowp = O + (size_t)row * ldc + col0;
                u32x4 w; w.x = pk2(o1[0][0], o1[0][1]); w.y = pk2(o1[0][2], o1[0][3]); w.z = pk2(o1[1][0], o1[1][1]); w.w = pk2(o1[1][2], o1[1][3]); *(u32x4*)rowp = w;
                w.x = pk2(o2[0][0], o2[0][1]); w.y = pk2(o2[0][2], o2[0][3]); w.z = pk2(o2[1][0], o2[1][1]); w.w = pk2(o2[1][2], o2[1][3]); *(u32x4*)(rowp + 32) = w;
            }
    }
};
struct EpiResid {
    static constexpr bool PERM = true, AFTER_DRAIN = false;
    const float* in_lat; const float* in_ctx; const bf16_t* in_bf; bf16_t* out_bf; float* out_f32; const float* gate;
    __device__ __forceinline__ void operator()(const f32x4 (&acc)[2][2][4][2], const Unit& u, int wr, int wc, int fr, int fq, PG8_LAS unsigned char*) const {
        const int col0 = u.pn * BM + wc * 32 + 8 * fq;
        const int bb = u.pm < MLAT / BM ? (u.pm >> 3) : NBATCH;
        const float* src = u.pm < MLAT / BM ? in_lat : in_ctx;
        f32x4 gv[2][2];
#pragma unroll
        for (int bj = 0; bj < 2; ++bj)
#pragma unroll
            for (int n = 0; n < 2; ++n) gv[bj][n] = *(const f32x4*)(gate + (size_t)bb * MODW + col0 + bj * HALF + n * 4);
#pragma unroll
        for (int ai = 0; ai < 2; ++ai)
#pragma unroll
            for (int m = 0; m < 4; ++m) { const size_t off = (size_t)(u.pm * BM + ai * HALF + wr * 64 + m * 16 + fr) * DM + col0;
#pragma unroll
                for (int bj = 0; bj < 2; ++bj) { f32x4 x0, x1;
                    if (in_bf) { const u32x4 r = *(const u32x4*)(in_bf + off + bj * HALF);
                        x0 = (f32x4){bf_lo(r.x), bf_hi(r.x), bf_lo(r.y), bf_hi(r.y)}; x1 = (f32x4){bf_lo(r.z), bf_hi(r.z), bf_lo(r.w), bf_hi(r.w)}; }
                    else { x0 = *(const f32x4*)(src + off + bj * HALF); x1 = *(const f32x4*)(src + off + bj * HALF + 4); }
                    x0 = x0 + gv[bj][0] * acc[ai][bj][m][0]; x1 = x1 + gv[bj][1] * acc[ai][bj][m][1];
                    if (out_f32) { *(f32x4*)(out_f32 + off + bj * HALF) = x0; *(f32x4*)(out_f32 + off + bj * HALF + 4) = x1; }
                    else { u32x4 w; w.x = pk2(x0[0], x0[1]); w.y = pk2(x0[2], x0[3]); w.z = pk2(x1[0], x1[1]); w.w = pk2(x1[2], x1[3]); *(u32x4*)(out_bf + off + bj * HALF) = w; } } }
    }
};
DI float dpp_ror1(float x) { return __int_as_float(__builtin_amdgcn_update_dpp(0, __float_as_int(x), 0x121, 0xf, 0xf, false)); }
DI float dpp_ror15(float x) { return __int_as_float(__builtin_amdgcn_update_dpp(0, __float_as_int(x), 0x12F, 0xf, 0xf, false)); }
struct EpiConv {
    static constexpr bool PERM = true, AFTER_DRAIN = false;
    bf16_t* ACT; float* HB; const float* cw; const float* cb;
    __device__ __forceinline__ void operator()(const f32x4 (&acc)[2][2][4][2], const Unit& u, int wr, int wc, int fr, int fq, PG8_LAS unsigned char* lds) const {
        PG8_LAS float* H = (PG8_LAS float*)(lds + STAGE_BYTES);
        const int chl = 32 * wc + 8 * fq, lane = 16 * fq + fr;
        PG8_LAS float* CW = (PG8_LAS float*)(lds + STAGE_BYTES + 8192);
        const int tid_e = (wr * 4 + wc) * 64 + lane, arr_e = tid_e >> 7, p2_e = (tid_e & 127) * 2;
        typedef float f32x2e __attribute__((ext_vector_type(2)));
        const f32x2e cw2 = *(const f32x2e*)((arr_e < 3 ? cw + arr_e * NUP : cb) + (p2_e >> 7) * DFF + 128 * u.pn + (p2_e & 127));
#pragma unroll
        for (int ai = 0; ai < 2; ++ai) { const int seg = 2 * ai + wr;
            if (fr == 0) {
#pragma unroll
                for (int bj = 0; bj < 2; ++bj)
#pragma unroll
                    for (int n = 0; n < 2; ++n) *(PG8_LAS f32x4*)(H + ((seg * 2 + 0) * 2 + bj) * 128 + chl + 4 * n) = acc[ai][bj][0][n]; }
            if (fr == 15) {
#pragma unroll
                for (int bj = 0; bj < 2; ++bj)
#pragma unroll
                    for (int n = 0; n < 2; ++n) *(PG8_LAS f32x4*)(H + ((seg * 2 + 1) * 2 + bj) * 128 + chl + 4 * n) = acc[ai][bj][3][n]; } }
        if (wr == 0 && fr < 2) { float* hb = HB + ((size_t)u.pm * 4 + fr) * NUP + 128 * u.pn + chl;
#pragma unroll
            for (int bj = 0; bj < 2; ++bj)
#pragma unroll
                for (int n = 0; n < 2; ++n) *(f32x4*)(hb + bj * DFF + 4 * n) = acc[0][bj][0][n]; }
        if (wr == 1 && fr >= 14) { float* hb = HB + ((size_t)u.pm * 4 + (fr - 12)) * NUP + 128 * u.pn + chl;
#pragma unroll
            for (int bj = 0; bj < 2; ++bj)
#pragma unroll
                for (int n = 0; n < 2; ++n) *(f32x4*)(hb + bj * DFF + 4 * n) = acc[1][bj][3][n]; }
        *(PG8_LAS f32x2e*)(CW + arr_e * 256 + p2_e) = cw2;
        asm volatile("s_waitcnt lgkmcnt(0)" ::: "memory"); __builtin_amdgcn_s_barrier(); asm volatile("" ::: "memory");
#pragma unroll
        for (int n = 0; n < 2; ++n) {
            const int colg = 128 * u.pn + chl + 4 * n;
#pragma unroll
            for (int ai = 0; ai < 2; ++ai) { const int seg = 2 * ai + wr;
                f32x4 cg[4];
#pragma unroll
                for (int bj = 0; bj < 2; ++bj) {
                    const PG8_LAS float* cwl = CW + 128 * bj + chl + 4 * n;
                    const f32x4 w0 = *(const PG8_LAS f32x4*)cwl, w1 = *(const PG8_LAS f32x4*)(cwl + 256), w2 = *(const PG8_LAS f32x4*)(cwl + 512), bs = *(const PG8_LAS f32x4*)(cwl + 768);
                    f32x4 hp = (f32x4){0.f, 0.f, 0.f, 0.f}, hn = hp;
                    if (seg > 0) hp = *(const PG8_LAS f32x4*)(H + (((seg - 1) * 2 + 1) * 2 + bj) * 128 + chl + 4 * n);
                    if (seg < 3) hn = *(const PG8_LAS f32x4*)(H + (((seg + 1) * 2 + 0) * 2 + bj) * 128 + chl + 4 * n);
#pragma unroll
                    for (int e = 0; e < 4; ++e) {
                        float v[4], rr[4], rl[4]; const float w0e = w0[e], w1e = w1[e], w2e = w2[e], bse = bs[e];
#pragma unroll
                        for (int m = 0; m < 4; ++m) { v[m] = acc[ai][bj][m][n][e]; rr[m] = dpp_ror1(v[m]); rl[m] = dpp_ror15(v[m]); }
#pragma unroll
                        for (int m = 0; m < 4; ++m) {
                            const float pv = fr != 0 ? rr[m] : (m > 0 ? rr[m > 0 ? m - 1 : 0] : hp[e]);
                            const float nv = fr != 15 ? rl[m] : (m < 3 ? rl[m < 3 ? m + 1 : 3] : hn[e]);
                            const float cvv = w0e * pv + w1e * v[m] + w2e * nv + bse;
                            if (bj == 0) cg[m][e] = cvv; else cg[m][e] = silu_f(cg[m][e]) * cvv;
                        }
                    }
                }
#pragma unroll
                for (int m = 0; m < 4; ++m) { const int row = u.pm * BM + ai * HALF + wr * 64 + m * 16 + fr;
                    uint2 w; w.x = pk2(cg[m][0], cg[m][1]); w.y = pk2(cg[m][2], cg[m][3]);
                    *(uint2*)(ACT + (size_t)row * DFF + colg) = w; }
            }
        }
    }
};
template <class Epi, class Sched, bool ALIGN_EPI = false, bool SP2 = false>
__device__ __forceinline__ void gemm_phase(PG8_LAS unsigned char* lds, const Gemm g, const Sched& S, const Epi& E, const int wid0) {
    int tid_l = wid0 * 64 + lane_id_opaque(); asm volatile("" : "+v"(tid_l));
    const int tid = tid_l, wid = __builtin_amdgcn_readfirstlane(tid >> 6), lane = tid & 63, wr = wid >> 2, wc = wid & 3, fr = lane & 15, fq = lane >> 4;
    const int K = g.K, nt = K / BK;
    unsigned voffA[2], voffB[2];
#pragma unroll
    for (int i = 0; i < 2; ++i) { int R, C; stage_rc(tid * 16 + i * 8192, R, C); const int Rb = Epi::PERM ? ((R & ~31) + perm32(R & 31)) : R;
        voffA[i] = (unsigned)(R * K + C) * 2u; voffB[i] = (unsigned)(Rb * K + C) * 2u; }
    const size_t kstep = (size_t)(BK * 2);
    const size_t hstep = (size_t)HALF * K * 2;
    const size_t tstep = 2 * hstep;
    const unsigned ldsw = (unsigned)wid * 1024u;
    const int aoff = lds_byte(wr * 64 + fr, fq * 8), boff = lds_byte(wc * 32 + fr, fq * 8);
#define PG8_SA(b, h) (((b) * 2 + (h)) * HTB)
#define PG8_SB(b, h) ((4 + (b) * 2 + (h)) * HTB)
#define PG8_STAGE(bufoff, gbase, voff) do { _Pragma("unroll") for (int _i = 0; _i < 2; ++_i) \
        __builtin_amdgcn_global_load_lds((const unsigned*)((const char*)(gbase) + (voff)[_i]), (PG8_LAS unsigned*)(lds + (bufoff) + ldsw + _i * 8192), 16, 0, 0); } while (0)
#define PG8_LDA(dst, b, h) do { _Pragma("unroll") for (int m = 0; m < 4; ++m) _Pragma("unroll") for (int k = 0; k < 2; ++k) dst[m][k] = *(const PG8_LAS bf16x8*)(lds + PG8_SA(b, h) + aoff + m * 2048 + k * 1024); } while (0)
#define PG8_LDB(dst, b, h) do { _Pragma("unroll") for (int n = 0; n < 2; ++n) _Pragma("unroll") for (int k = 0; k < 2; ++k) dst[n][k] = *(const PG8_LAS bf16x8*)(lds + PG8_SB(b, h) + boff + n * 2048 + k * 1024); } while (0)
#define PG8_MMA(ai, bj, At, Bt) do { __builtin_amdgcn_s_setprio(1); _Pragma("unroll") for (int m = 0; m < 4; ++m) _Pragma("unroll") for (int n = 0; n < 2; ++n) _Pragma("unroll") for (int k = 0; k < 2; ++k) \
        acc[ai][bj][m][n] = __builtin_amdgcn_mfma_f32_16x16x32_bf16(Bt[n][k], At[m][k], acc[ai][bj][m][n], 0, 0, 0); __builtin_amdgcn_s_setprio(0); } while (0)
#define PG8_WAIT_V(n) asm volatile("s_waitcnt vmcnt(" #n ")" ::: "memory")
#define PG8_WAIT_L(n) asm volatile("s_waitcnt lgkmcnt(" #n ")" ::: "memory")
#define PG8_BAR __builtin_amdgcn_s_barrier()
#define PG8_SCHED __builtin_amdgcn_sched_barrier(0)
    Unit cur, nxt; int ui = 0;
    if (!S.next(0, cur)) return;
    f32x4 acc[2][2][4][2];
#pragma unroll
    for (int a = 0; a < 2; ++a)
#pragma unroll
        for (int b = 0; b < 2; ++b)
#pragma unroll
            for (int m = 0; m < 4; ++m)
#pragma unroll
                for (int n = 0; n < 2; ++n) acc[a][b][m][n] = (f32x4){0.f, 0.f, 0.f, 0.f};
    bf16x8 At[4][2], B0[2][2], B1[2][2];
    const char* cA = (const char*)g.A + (size_t)cur.pm * tstep; const char* cB = (const char*)g.Bt + (size_t)cur.pn * tstep;
    S.a_ready(cur);
    if constexpr (SP2) {
        PG8_STAGE(PG8_SB(0, 0), cB, voffB); PG8_STAGE(PG8_SB(0, 1), cB + hstep, voffB); PG8_STAGE(PG8_SA(0, 0), cA, voffA); PG8_STAGE(PG8_SA(0, 1), cA + hstep, voffA);
        if (wr == 1) PG8_BAR;
        PG8_WAIT_V(2); PG8_BAR;
        PG8_STAGE(PG8_SB(1, 0), cB + kstep, voffB); PG8_STAGE(PG8_SA(1, 0), cA + kstep, voffA); PG8_STAGE(PG8_SB(1, 1), cB + hstep + kstep, voffB);
        PG8_WAIT_V(6); PG8_BAR;
    } else {
        PG8_STAGE(PG8_SB(0, 0), cB, voffB); PG8_STAGE(PG8_SA(0, 0), cA, voffA); PG8_STAGE(PG8_SB(0, 1), cB + hstep, voffB); PG8_STAGE(PG8_SA(0, 1), cA + hstep, voffA);
        if (wr == 1) PG8_BAR;
        PG8_WAIT_V(4); PG8_BAR;
        PG8_STAGE(PG8_SB(1, 0), cB + kstep, voffB); PG8_STAGE(PG8_SA(1, 0), cA + kstep, voffA); PG8_STAGE(PG8_SB(1, 1), cB + hstep + kstep, voffB);
        PG8_WAIT_V(6); PG8_BAR;
    }
    for (;;) {
        const bool has_next = S.next(ui + 1, nxt);
        const char* nA = has_next ? (const char*)g.A + (size_t)nxt.pm * tstep : cA; const char* nB = has_next ? (const char*)g.Bt + (size_t)nxt.pn * tstep : cB;
        for (int t = 0; t < nt; t += 2) {
            const bool last = (t == nt - 2);
            const char* a1 = cA + (size_t)(t + 1) * kstep;
            const char* a2 = last ? nA : cA + (size_t)(t + 2) * kstep; const char* b2 = last ? nB : cB + (size_t)(t + 2) * kstep;
            const char* a3 = a2 + kstep; const char* b3 = b2 + kstep;
            if (last && has_next) S.a_ready(nxt);
            if constexpr (SP2) {
            PG8_LDB(B0, 0, 0); PG8_LDB(B1, 0, 1); PG8_SCHED; PG8_LDA(At, 0, 0); PG8_STAGE(PG8_SA(1, 1), a1 + hstep, voffA);
            PG8_WAIT_V(8); PG8_WAIT_L(0); PG8_BAR; PG8_MMA(0, 0, At, B0); PG8_MMA(0, 1, At, B1); PG8_BAR; PG8_SCHED;
            PG8_LDA(At, 0, 1); PG8_STAGE(PG8_SB(0, 0), b2, voffB); PG8_STAGE(PG8_SB(0, 1), b2 + hstep, voffB); PG8_STAGE(PG8_SA(0, 0), a2, voffA);
            PG8_WAIT_V(8); PG8_WAIT_L(0); PG8_BAR; PG8_MMA(1, 0, At, B0); PG8_MMA(1, 1, At, B1); PG8_BAR; PG8_SCHED;
            PG8_LDB(B0, 1, 0); PG8_LDB(B1, 1, 1); PG8_SCHED; PG8_LDA(At, 1, 0); PG8_STAGE(PG8_SA(0, 1), a2 + hstep, voffA);
            PG8_WAIT_V(8); PG8_WAIT_L(0); PG8_BAR; PG8_MMA(0, 0, At, B0); PG8_MMA(0, 1, At, B1); PG8_BAR; PG8_SCHED;
            PG8_LDA(At, 1, 1); PG8_STAGE(PG8_SB(1, 0), b3, voffB); PG8_STAGE(PG8_SB(1, 1), b3 + hstep, voffB); PG8_STAGE(PG8_SA(1, 0), a3, voffA);
            PG8_WAIT_V(8); PG8_WAIT_L(0); PG8_BAR; PG8_MMA(1, 0, At, B0); PG8_MMA(1, 1, At, B1); PG8_BAR; PG8_SCHED;
            } else {
            PG8_LDB(B0, 0, 0); PG8_SCHED; PG8_LDA(At, 0, 0); PG8_STAGE(PG8_SA(1, 1), a1 + hstep, voffA);
            PG8_WAIT_L(8); PG8_BAR; PG8_WAIT_L(0); PG8_MMA(0, 0, At, B0); PG8_BAR; PG8_SCHED;
            PG8_LDB(B1, 0, 1); PG8_STAGE(PG8_SB(0, 0), b2, voffB);
            PG8_BAR; PG8_WAIT_L(0); PG8_MMA(0, 1, At, B1); PG8_BAR;
            PG8_LDA(At, 0, 1); PG8_STAGE(PG8_SA(0, 0), a2, voffA);
            PG8_BAR; PG8_WAIT_L(0); PG8_MMA(1, 0, At, B0); PG8_BAR; PG8_SCHED;
            PG8_STAGE(PG8_SB(0, 1), b2 + hstep, voffB);
            PG8_WAIT_V(6); PG8_BAR; PG8_MMA(1, 1, At, B1); PG8_BAR;
            PG8_LDB(B0, 1, 0); PG8_SCHED; PG8_LDA(At, 1, 0); PG8_STAGE(PG8_SA(0, 1), a2 + hstep, voffA);
            PG8_WAIT_L(8); PG8_BAR; PG8_WAIT_L(0); PG8_MMA(0, 0, At, B0); PG8_BAR; PG8_SCHED;
            PG8_LDB(B1, 1, 1); PG8_STAGE(PG8_SB(1, 0), b3, voffB);
            PG8_BAR; PG8_WAIT_L(0); PG8_MMA(0, 1, At, B1); PG8_BAR;
            PG8_LDA(At, 1, 1); PG8_STAGE(PG8_SA(1, 0), a3, voffA);
            PG8_BAR; PG8_WAIT_L(0); PG8_MMA(1, 0, At, B0); PG8_BAR; PG8_SCHED;
            PG8_STAGE(PG8_SB(1, 1), b3 + hstep, voffB);
            PG8_WAIT_V(6); PG8_BAR; PG8_MMA(1, 1, At, B1); PG8_BAR;
            }
        }
        if constexpr (ALIGN_EPI) { if (wr == 0) PG8_BAR; }
        if constexpr (!Epi::AFTER_DRAIN) { E(acc, cur, wr, wc, fr, fq, lds); S.done(cur); }
        if (!has_next) break;
#pragma unroll
        for (int a = 0; a < 2; ++a)
#pragma unroll
            for (int b = 0; b < 2; ++b)
#pragma unroll
                for (int m = 0; m < 4; ++m)
#pragma unroll
                    for (int n = 0; n < 2; ++n) acc[a][b][m][n] = (f32x4){0.f, 0.f, 0.f, 0.f};
        cur = nxt; cA = nA; cB = nB; ++ui;
        if constexpr (ALIGN_EPI) { if (wr == 1) PG8_BAR; }
    }
    PG8_WAIT_V(0);
    if constexpr (!ALIGN_EPI) { if (wr == 0) PG8_BAR; }
    PG8_BAR;
    if constexpr (Epi::AFTER_DRAIN) { E.fused(acc, cur, wr, wc, fr, fq, lds, wid, lane); S.done(cur); }
#undef PG8_SA
#undef PG8_SB
#undef PG8_STAGE
#undef PG8_LDA
#undef PG8_LDB
#undef PG8_MMA
#undef PG8_WAIT_V
#undef PG8_WAIT_L
#undef PG8_BAR
#undef PG8_SCHED
}
}
namespace att {
typedef unsigned short bf16_t;
typedef short bf16x8 __attribute__((ext_vector_type(8)));
typedef short s16x4 __attribute__((ext_vector_type(4)));
typedef float f32x16 __attribute__((ext_vector_type(16)));
typedef float f32x4 __attribute__((ext_vector_type(4)));
typedef unsigned u32x4 __attribute__((ext_vector_type(4)));
constexpr int KP = 72;
constexpr int K_BYTES = 2 * 64 * KP * 2;
constexpr int V_BYTES = 3 * 64 * 160 * 2;
constexpr int SC_OFF = K_BYTES + V_BYTES, STASH_OFF = SC_OFF + 1024, ATT_LDS = STASH_OFF + 8 * 8192;
#define MFMA32(a, b, c) __builtin_amdgcn_mfma_f32_32x32x16_bf16((a), (b), (c), 0, 0, 0)
DI float max3f(float x, float y, float z) { return __builtin_fmaxf(__builtin_fmaxf(x, y), z); }
DI float halfmax(float v) { auto rr = __builtin_amdgcn_permlane32_swap(__float_as_uint(v), __float_as_uint(v), false, false); return __builtin_fmaxf(__uint_as_float(rr[0]), __uint_as_float(rr[1])); }
DI float halfsum(float v) { auto rr = __builtin_amdgcn_permlane32_swap(__float_as_uint(v), __float_as_uint(v), false, false); return __uint_as_float(rr[0]) + __uint_as_float(rr[1]); }
constexpr float THR = 8.f;
DI s16x4 vtr(const LAS bf16_t* p) { return __builtin_bit_cast(s16x4, __builtin_amdgcn_ds_read_tr16_b64_v4i16((LAS s16x4*)p)); }

template <int MODE>
DI void attn_phase(LAS unsigned char* lds, const bf16_t* __restrict__ QKV, const int ldq, bf16_t* __restrict__ O,
                   const float* lam_p, const float* head_g, const float lam_init, const float* sink, const bool need_ctx, const int vb, const int G, const int wid0) {
    constexpr int DV = MODE == 0 ? 128 : 64, DT = DV / 32, VP = DV == 64 ? 96 : 160  , NH = MODE == 0 ? 8 : 16, NPASS = MODE == 0 ? 2 : 1;
    int tid_l = wid0 * 64 + lane_id_opaque(); asm volatile("" : "+v"(tid_l));
    const int tid = tid_l, lane = tid & 63, r = lane & 31, h = lane >> 5, w = __builtin_amdgcn_readfirstlane(tid >> 6);
    const int i16 = lane & 15, q4 = i16 >> 2, p4 = i16 & 3, blk = (lane >> 4) & 1;
    LAS bf16_t* Ks = (LAS bf16_t*)lds; LAS bf16_t* Vs = (LAS bf16_t*)(lds + K_BYTES);
    LAS float* sc = (LAS float*)(lds + SC_OFF) + w * 32;
    LAS unsigned* stash = (LAS unsigned*)(lds + STASH_OFF) + w * 2048;
    const int lrow = tid >> 3, lch = tid & 7;
    float lam = 0.f;
    if (MODE == 0) { float a = lam_p[lane] * lam_p[64 + lane], b2 = lam_p[128 + lane] * lam_p[192 + lane];
#pragma unroll
        for (int o = 1; o < 64; o <<= 1) { a += __shfl_xor(a, o); b2 += __shfl_xor(b2, o); }
        lam = expf(a) - expf(b2) + lam_init; lam = __uint_as_float(__builtin_amdgcn_readfirstlane(__float_as_uint(lam))); }
    const int NLAT = NBATCH * NH * 8, NU = NLAT + (need_ctx ? NBATCH * NH : 0);
#pragma unroll 1
    for (int u = vb; u < NU; u += G) {
        int b, hd, qb; bool isctx = u >= NLAT;
        if (!isctx) { qb = u & 7; hd = (u >> 3) % NH; b = u / (8 * NH); } else { const int v = u - NLAT; qb = 0; hd = v % NH; b = v / NH; }
        const int qrow0 = isctx ? MLAT + b * CTXL : b * SEQL + 256 * qb;
        int t0 = 0, nl = 0;
        if (!isctx) { if (MODE == 2) { t0 = 4 * qb - 2 < 0 ? 0 : 4 * qb - 2; const int t1 = 4 * qb + 5 > 31 ? 31 : 4 * qb + 5; nl = t1 - t0 + 1; } else { nl = 32; } }
        const int nt = nl + 4;
        const int qw = 256 * qb + 32 * w;
        f32x16 o[DT];
#pragma unroll 1
        for (int pass = 0; pass < NPASS; ++pass) {
            const int qcol = MODE == 0 ? hd * 128 + pass * 64 : hd * 64;
            const int kcol = MODE == 0 ? 1024 + hd * 128 + pass * 64 : 1024 + (hd >> 2) * 64;
            const int vcol = MODE == 0 ? 2048 + hd * 128 : 1280 + (hd >> 2) * 64;
            bf16x8 qf[4];
            { const bf16_t* qp = QKV + (size_t)(qrow0 + 32 * w + r) * ldq + qcol + 8 * h;
#pragma unroll
              for (int s = 0; s < 4; ++s) qf[s] = *(const bf16x8*)(qp + 16 * s); }
            f32x16 negm;
#pragma unroll
            for (int i = 0; i < 16; ++i) negm[i] = 0.f;
            float m = 0.f, lsum = 0.f; bool valid = false;
#pragma unroll
            for (int dt = 0; dt < DT; ++dt)
#pragma unroll
                for (int i = 0; i < 16; ++i) o[dt][i] = 0.f;
            __syncthreads();
            const LAS bf16_t* klane = Ks + r * KP + 8 * h; const LAS bf16_t* vlane = Vs + (4 * h + q4) * VP + 16 * blk + 4 * p4;
            constexpr int PD = 3, NLD = 1 + DT / 2;
            u32x4 kq[PD], vq[PD][DT / 2];
#define TILE_ROW(tt) ((tt) < nl ? b * SEQL + 64 * (t0 + (tt)) : MLAT + b * CTXL + 64 * ((tt) - nl))
#define GLOAD16(dst, ptr) asm volatile("global_load_dwordx4 %0, %1, off" : "=v"(dst) : "v"(ptr) : "memory")
#define LOAD_TILE(pi_, tt) do { const bf16_t* gp_ = QKV + (size_t)(TILE_ROW(tt) + lrow) * ldq; GLOAD16(kq[pi_], gp_ + kcol + 8 * lch); \
            _Pragma("unroll") for (int j_ = 0; j_ < DT / 2; ++j_) GLOAD16(vq[pi_][j_], gp_ + vcol + 8 * lch + 64 * j_); } while (0)
            asm volatile("" :: "v"(qf[0]), "v"(qf[1]), "v"(qf[2]), "v"(qf[3]));
#pragma unroll
            for (int pi = 0; pi < PD; ++pi) LOAD_TILE(pi, pi);
#pragma unroll 1
            for (int tb = 0; tb < nt; tb += PD) {
#pragma unroll
              for (int pi = 0; pi < PD; ++pi) { const int t = tb + pi; if (t < nt) {
                const int buf = t & 1, vslot = t % 3;
                if (PD == 3 && t + 2 < nt) { if (NLD == 2) asm volatile("s_waitcnt vmcnt(4)" ::: "memory"); else asm volatile("s_waitcnt vmcnt(6)" ::: "memory"); }
                else if (t + 1 < nt) { if (NLD == 2) asm volatile("s_waitcnt vmcnt(2)" ::: "memory"); else asm volatile("s_waitcnt vmcnt(3)" ::: "memory"); }
                else asm volatile("s_waitcnt vmcnt(0)" ::: "memory");
                asm volatile("" : "+v"(kq[pi]));
#pragma unroll
                for (int j = 0; j < DT / 2; ++j) asm volatile("" : "+v"(vq[pi][j]));
                *(LAS u32x4*)(Ks + (buf * 64 + lrow) * KP + 8 * lch) = kq[pi];
#pragma unroll
                for (int j = 0; j < DT / 2; ++j) *(LAS u32x4*)(Vs + (vslot * 64 + lrow) * VP + 8 * lch + 64 * j) = vq[pi][j];
                asm volatile("s_waitcnt lgkmcnt(0)\n\ts_barrier" ::: "memory");
                if (t + PD < nt) LOAD_TILE(pi, t + PD);
                const bool lat_tile = t < nl; const int kpos0 = 64 * (t0 + t);
                bool skip = false, domask = false;
                if (MODE == 2 && lat_tile) { skip = (kpos0 > qw + 31 + 128) || (kpos0 + 63 < qw - 128); domask = !((kpos0 + 63 <= qw + 128) && (kpos0 >= qw + 31 - 128)); }
                if (!skip) {
                    const LAS bf16_t* Kt = klane + buf * 64 * KP; const LAS bf16_t* Vt = vlane + vslot * 64 * VP;
                    f32x16 pA, pB;
                    bf16x8 kfA[4], kfB[4], vf[2][DT];
#define VFRAG_LOAD(dst, HH) do { _Pragma("unroll") for (int kk_ = 0; kk_ < 2; ++kk_) _Pragma("unroll") for (int dt_ = 0; dt_ < DT; ++dt_) { \
                        const LAS bf16_t* vp_ = Vt + (16 * (2 * (HH) + kk_) * VP + 32 * dt_); const s16x4 lo_ = vtr(vp_), hi_ = vtr(vp_ + 8 * VP); \
                        dst[kk_][dt_] = __builtin_shufflevector(lo_, hi_, 0, 1, 2, 3, 4, 5, 6, 7); } } while (0)
                    if constexpr (MODE != 0) {
#pragma unroll
                        for (int s = 0; s < 4; ++s) { kfA[s] = *(const LAS bf16x8*)(Kt + 16 * s); kfB[s] = *(const LAS bf16x8*)(Kt + (32 * KP + 16 * s)); }
                        __builtin_amdgcn_sched_barrier(0);
#pragma unroll
                        for (int s = 0; s < 4; ++s) { if (s == 0) { pA = MFMA32(kfA[0], qf[0], negm); pB = MFMA32(kfB[0], qf[0], negm); } else { pA = MFMA32(kfA[s], qf[s], pA); pB = MFMA32(kfB[s], qf[s], pB); } }
                    } else {
#pragma unroll
                        for (int s = 0; s < 4; ++s) kfA[s] = *(const LAS bf16x8*)(Kt + 16 * s);
                        __builtin_amdgcn_sched_barrier(0);
#pragma unroll
                        for (int s = 0; s < 4; ++s) { if (s == 0) pA = MFMA32(kfA[0], qf[0], negm); else pA = MFMA32(kfA[s], qf[s], pA); }
                    }
                    if (MODE == 2 && domask) { const int qpos = qw + r;
#pragma unroll
                        for (int i = 0; i < 16; ++i) { const int d0 = kpos0 + (i & 3) + 8 * (i >> 2) + 4 * h - qpos;
                            if (d0 > 128 || d0 < -128) pA[i] = -INFINITY;
                            if (d0 + 32 > 128 || d0 + 32 < -128) pB[i] = -INFINITY; } }
#define VKK_LOAD(dst, KS) do { _Pragma("unroll") for (int dt_ = 0; dt_ < DT; ++dt_) { const LAS bf16_t* vp_ = Vt + (16 * (KS) * VP + 32 * dt_); const s16x4 lo_ = vtr(vp_), hi_ = vtr(vp_ + 8 * VP); \
                        dst[dt_] = __builtin_shufflevector(lo_, hi_, 0, 1, 2, 3, 4, 5, 6, 7); } } while (0)
#define HALF_STEP(P, HH, OTHER_FIX) do { \
                    if constexpr (MODE != 0) { VFRAG_LOAD(vf, HH); __builtin_amdgcn_sched_barrier(0); }     \
                    else { VKK_LOAD(vf[0], 2 * (HH)); __builtin_amdgcn_sched_barrier(0); }                 \
                    float mt_; \
                    { float xa_ = max3f(P[0], P[1], P[2]), xb_ = max3f(P[3], P[4], P[5]); \
                      xa_ = max3f(xa_, P[6], P[7]); xb_ = max3f(xb_, P[8], P[9]); xa_ = max3f(xa_, P[10], P[11]); xb_ = max3f(xb_, P[12], P[13]); xa_ = max3f(xa_, P[14], P[15]); \
                      mt_ = halfmax(__builtin_fmaxf(xa_, xb_)); } \
                    const bool upd_ = valid ? (mt_ > THR) : (mt_ > -INFINITY); \
                    if (__any(upd_)) { \
                        const float dl = upd_ ? mt_ : 0.f; \
                        const float alpha_ = valid ? __builtin_amdgcn_exp2f(-dl) : 1.f; \
                        m += dl; valid = valid || upd_; \
                        _Pragma("unroll") for (int i_ = 0; i_ < 16; ++i_) negm[i_] = -m; \
                        _Pragma("unroll") for (int i_ = 0; i_ < 16; ++i_) P[i_] -= dl; \
                        OTHER_FIX; \
                        lsum *= alpha_; \
                        if (h == 0) sc[r] = alpha_; \
                        asm volatile("s_waitcnt lgkmcnt(0)" ::: "memory"); \
                        _Pragma("unroll") for (int g_ = 0; g_ < 4; ++g_) { const f32x4 a4_ = *(const LAS f32x4*)(sc + 8 * g_ + 4 * h); \
                            _Pragma("unroll") for (int dt_ = 0; dt_ < DT; ++dt_) \
                                _Pragma("unroll") for (int j_ = 0; j_ < 4; ++j_) o[dt_][4 * g_ + j_] *= a4_[j_]; } \
                        asm volatile("s_waitcnt lgkmcnt(0)" ::: "memory"); \
                    } \
                    float ps_ = 0.f; \
                    _Pragma("unroll") for (int i_ = 0; i_ < 16; ++i_) { P[i_] = __builtin_amdgcn_exp2f(P[i_]); ps_ += P[i_]; } \
                    lsum += ps_; \
                    _Pragma("unroll") for (int kk_ = 0; kk_ < 2; ++kk_) { u32x4 wv_; \
                        _Pragma("unroll") for (int j_ = 0; j_ < 4; ++j_) wv_[j_] = pk2(P[8 * kk_ + 2 * j_], P[8 * kk_ + 2 * j_ + 1]); \
                        const bf16x8 pfk_ = __builtin_bit_cast(bf16x8, wv_); \
                        if (MODE == 0 && kk_ == 0) { VKK_LOAD(vf[1], 2 * (HH) + 1); __builtin_amdgcn_sched_barrier(0); }     \
                        _Pragma("unroll") for (int dt_ = 0; dt_ < DT; ++dt_) o[dt_] = MFMA32(pfk_, vf[kk_][dt_], o[dt_]); } } while (0)
                    if constexpr (MODE != 0) {
                        HALF_STEP(pA, 0, _Pragma("unroll") for (int i_ = 0; i_ < 16; ++i_) pB[i_] -= dl);
                        HALF_STEP(pB, 1, (void)0);
                    } else {
                        HALF_STEP(pA, 0, (void)0);
#pragma unroll
                        for (int s = 0; s < 4; ++s) kfB[s] = *(const LAS bf16x8*)(Kt + (32 * KP + 16 * s));
                        __builtin_amdgcn_sched_barrier(0);
#pragma unroll
                        for (int s = 0; s < 4; ++s) { if (s == 0) pB = MFMA32(kfB[0], qf[0], negm); else pB = MFMA32(kfB[s], qf[s], pB); }
                        HALF_STEP(pB, 1, (void)0);
                    }
#undef HALF_STEP
#undef VKK_LOAD
#undef VFRAG_LOAD
                }
            } } }
#undef LOAD_TILE
#undef GLOAD16
#undef TILE_ROW
            float lt = halfsum(lsum);
            if (MODE == 2) lt += __builtin_amdgcn_exp2f(sink[hd] * 1.4426950408889634f - m);
            const float inv = 1.f / lt;
            if (h == 0) sc[r] = inv;
            asm volatile("s_waitcnt lgkmcnt(0)" ::: "memory");
#pragma unroll
            for (int g = 0; g < 4; ++g) { const f32x4 a4 = *(const LAS f32x4*)(sc + 8 * g + 4 * h);
#pragma unroll
                for (int dt = 0; dt < DT; ++dt)
#pragma unroll
                    for (int j = 0; j < 4; ++j) o[dt][4 * g + j] *= a4[j]; }
            asm volatile("s_waitcnt lgkmcnt(0)" ::: "memory");
            if (MODE == 0 && pass == 0) {
#pragma unroll
                for (int dt = 0; dt < DT; ++dt)
#pragma unroll
                    for (int j = 0; j < 8; ++j) stash[(dt * 8 + j) * 64 + lane] = pk2(o[dt][2 * j], o[dt][2 * j + 1]);
            }
        }
        if (MODE == 0) {
            float ssq[16];
#pragma unroll
            for (int i = 0; i < 16; ++i) ssq[i] = 0.f;
#pragma unroll
            for (int dt = 0; dt < DT; ++dt)
#pragma unroll
                for (int j = 0; j < 8; ++j) { const unsigned pk = stash[(dt * 8 + j) * 64 + lane];
                    const float a0 = bf_lo(pk) - lam * o[dt][2 * j], a1 = bf_hi(pk) - lam * o[dt][2 * j + 1];
                    o[dt][2 * j] = a0; o[dt][2 * j + 1] = a1; ssq[2 * j] += a0 * a0; ssq[2 * j + 1] += a1 * a1; }
#pragma unroll
            for (int i = 0; i < 16; ++i) {
#pragma unroll
                for (int off = 1; off < 32; off <<= 1) ssq[i] += __shfl_xor(ssq[i], off);
                ssq[i] = __builtin_amdgcn_rsqf(ssq[i] * (1.f / 128.f) + EPSN) * (1.f - lam_init); }
#pragma unroll
            for (int dt = 0; dt < DT; ++dt) { const float hg = head_g[32 * dt + r];
#pragma unroll
                for (int i = 0; i < 16; ++i) o[dt][i] *= ssq[i] * hg; }
        }
        { bf16_t* op = O + (size_t)(qrow0 + 32 * w) * DM + hd * DV + r;
#pragma unroll
          for (int dt = 0; dt < DT; ++dt)
#pragma unroll
              for (int i = 0; i < 16; ++i) { const int row = (i & 3) + 8 * (i >> 2) + 4 * h; op[(size_t)row * DM + 32 * dt] = (bf16_t)(pk2(o[dt][i], 0.f) & 0xffffu); } }
    }
}
#undef MFMA32
}
typedef unsigned short bf16;
typedef float f32x4 __attribute__((ext_vector_type(4)));
typedef unsigned v4u __attribute__((ext_vector_type(4)));
constexpr int NWAVES = 8, NTHREADS = 512;
constexpr size_t MiB = 1u << 20;
constexpr size_t WS_MOD = 0, WS_ROPE = 2 * MiB, WS_HB = 3 * MiB, WS_WQKV = 16 * MiB, WS_WO = 22 * MiB, WS_WUP = 24 * MiB, WS_WDN = 35 * MiB,
                 WS_X = 41 * MiB, WS_HN = 185 * MiB, WS_QKV = 257 * MiB, WS_END = 473 * MiB;
static_assert((size_t)DEPTH * NMODB * MODW * 4 <= 2 * MiB && (size_t)144 * 4 * NUP * 4 <= 13 * MiB && (size_t)NUP * DM * 2 <= 11 * MiB && (size_t)DM * DFF * 2 <= 6 * MiB, "ws map");
static_assert((size_t)MTOT * DM * 4 == 144 * MiB && (size_t)MTOT * DM * 2 == 72 * MiB && (size_t)MTOT * 3072 * 2 == 216 * MiB && (size_t)MTOT * DFF * 2 <= 216 * MiB, "ws map 2");
constexpr size_t WS_CTL = 2 * MiB + 768 * 1024, CTL_ZERO_BYTES = 16384;
constexpr int MISC_OFF = 163840 - 256;
constexpr int LDS_BYTES = 163840;

#ifndef PHM
#define PHM 0xffff
#endif
#ifndef X_SYNC
#define X_SYNC 0
#endif
#ifndef X_ATT
#define X_ATT 1
#endif
#ifndef X_UP
#define X_UP 1
#endif
#ifndef X_QKV
#define X_QKV 1
#endif
#ifndef X_NORM
#define X_NORM 1
#endif
#define GSYNC() do { XcdBarrier xb_ = xbar; unsigned* bp_ = (unsigned*)(a.ws + WS_CTL); asm volatile("" : "+s"(bp_)); xb_.bar = bp_;     \
    xcd_barrier(xb_); for (int xs_ = 0; xs_ < X_SYNC; ++xs_) xcd_barrier(xb_); } while (0)
#define GAS __attribute__((address_space(1)))
typedef GAS unsigned gu32;
typedef GAS unsigned long long gu64;
#define RLX_AGENT __ATOMIC_RELAXED, __HIP_MEMORY_SCOPE_AGENT
#define LDS_WAIT() asm volatile("s_waitcnt lgkmcnt(0)" ::: "memory")
#define VM_WAIT() asm volatile("s_waitcnt vmcnt(0)" ::: "memory")
__device__ __forceinline__ unsigned long long rt() { return __builtin_amdgcn_s_memrealtime(); }
#define XB_TMO      128
#define XB_XCNT(j)  (256  + 64 * (j))
#define XB_XSUB(j)  (1280 + 64 * (j))
#define XB_XGEN(j)  (2304 + 64 * (j))
#define XB_TOP      3328
#define XB_TOPGEN   3392
#define XCD_BAR_WORDS 3456
#define XB_SPIN_CAP (1u << 18)

__device__ __forceinline__ unsigned xb_ld(unsigned* p)              { return __hip_atomic_load(p, __ATOMIC_RELAXED, __HIP_MEMORY_SCOPE_AGENT); }
__device__ __forceinline__ unsigned xb_add(unsigned* p, unsigned v) { return __hip_atomic_fetch_add(p, v, __ATOMIC_RELAXED, __HIP_MEMORY_SCOPE_AGENT); }
__device__ __forceinline__ unsigned xb_xcc_id() { return (unsigned)__builtin_amdgcn_s_getreg((3 << 11) | 20) & 0xFu; }
#define XB_SPIN(cond, bar) do { unsigned _sp = 0; while (cond) { __builtin_amdgcn_s_sleep(1); \
    if ((++_sp & 255u) == 0u) { if (xb_ld(&(bar)[XB_TMO])) break; if (_sp > XB_SPIN_CAP) { atomicAdd(&(bar)[XB_TMO], 1u); break; } } } } while (0)

struct XcdBarrier {
    unsigned* bar; unsigned x;
    volatile LAS unsigned* st;
};

__device__ __forceinline__ XcdBarrier xcd_barrier_post(unsigned* bar, volatile LAS unsigned* st) {
    XcdBarrier b; b.bar = bar; b.x = xb_xcc_id(); b.st = st;
    if (threadIdx.x == 0) (void)xb_add(&bar[XB_XCNT(b.x)], 1u);
    return b;
}
__device__ __forceinline__ void xcd_barrier_complete(unsigned* bar, unsigned x, unsigned& nloc, unsigned& nx) {
    const unsigned G = gridDim.x * gridDim.y * gridDim.z;
    unsigned sum, cnt, mine, sp = 0u;
    for (;;) {
        sum = 0u; cnt = 0u; mine = 0u;
#pragma unroll
        for (unsigned j = 0; j < 16; ++j) { const unsigned c = xb_ld(&bar[XB_XCNT(j)]); sum += c; cnt += (c > 0u) ? 1u : 0u; mine = (j == x) ? c : mine; }
        if (sum == G) break;
        __builtin_amdgcn_s_sleep(1);
        if ((++sp & 255u) == 0u) { if (xb_ld(&bar[XB_TMO])) break; if (sp > XB_SPIN_CAP) { atomicAdd(&bar[XB_TMO], 1u); break; } }
    }
    nloc = mine > 0u ? mine : 1u; nx = cnt > 0u ? cnt : 1u;
}

__device__ __forceinline__ void xcd_barrier(const XcdBarrier& b) {
    asm volatile("s_waitcnt vmcnt(0)" ::: "memory");
    __syncthreads();
    if (threadIdx.x == 0) {
        unsigned* bar = b.bar;
        __builtin_amdgcn_s_waitcnt(0);
        unsigned nloc = b.st[0], nx = b.st[1];
        if (nloc == 0u) { xcd_barrier_complete(bar, b.x, nloc, nx); b.st[0] = nloc; b.st[1] = nx; }
        const unsigned old = xb_add(&bar[XB_XSUB(b.x)], 1u);
        const unsigned gen = old / nloc;
        if (old + 1u == (gen + 1u) * nloc) {
            __builtin_amdgcn_fence(__ATOMIC_RELEASE, "agent");
            asm volatile("s_waitcnt vmcnt(0)" ::: "memory");
            const unsigned og = xb_add(&bar[XB_TOP], 1u);
            const unsigned tg = og / nx;
            if (og + 1u == (tg + 1u) * nx) xb_add(&bar[XB_TOPGEN], 1u);
            else XB_SPIN(xb_ld(&bar[XB_TOPGEN]) == tg, bar);
            __builtin_amdgcn_fence(__ATOMIC_ACQUIRE, "agent");
            xb_add(&bar[XB_XGEN(b.x)], 1u);
            asm volatile("s_waitcnt vmcnt(0)" ::: "memory");
        } else {
            XB_SPIN(xb_ld(&bar[XB_XGEN(b.x)]) == gen, bar);
            __builtin_amdgcn_fence(__ATOMIC_ACQUIRE, "agent");
            asm volatile("s_waitcnt vmcnt(0)" ::: "memory");
        }
    }
    __syncthreads();
}

struct Args {
    const float *x, *c, *ctx, *c_ctx, *adaln_w, *adaln_b, *norm1_g, *norm2_g, *ffn_w_up, *ffn_conv_w, *ffn_conv_b, *ffn_w_down,
                *a_w_qkv, *a_qk_g, *a_lambda, *a_head_g, *a_w_o, *b_w_qkv, *b_qk_g, *b_w_o, *c_w_qkv, *c_qk_g, *c_sink, *c_w_o;
    float* out; unsigned char* ws;
};

#define DPP_F(x, ctrl) __int_as_float(__builtin_amdgcn_update_dpp(0, __float_as_int(x), (ctrl), 0xf, 0xf, false))
DI float wave_sum(float v) {
    v += DPP_F(v, 0xB1);
    v += DPP_F(v, 0x4E);
    v += DPP_F(v, 0x141);
    v += DPP_F(v, 0x140);
    v += __shfl_xor(v, 16);
    { auto rr = __builtin_amdgcn_permlane32_swap(__float_as_uint(v), __float_as_uint(v), false, false); v = __uint_as_float(rr[0]) + __uint_as_float(rr[1]); }
    return v;
}
DI void transpose_item(const float* W, int K, int N, bf16* WT, int k0, int n0, int dst_row0, LAS float* scr, int lane) {
    float wreg[32];
#pragma unroll
    for (int i = 0; i < 32; ++i) { const int kk = 2 * i + (lane >> 5); wreg[i] = W[(size_t)(k0 + kk) * N + n0 + (lane & 31)]; }
#pragma unroll
    for (int i = 0; i < 32; ++i) { const int kk = 2 * i + (lane >> 5); scr[kk * 33 + (lane & 31)] = wreg[i]; }
    asm volatile("s_waitcnt lgkmcnt(0)" ::: "memory");
    const int c = lane & 7;
#pragma unroll
    for (int j = 0; j < 4; ++j) { const int n = (lane >> 3) + 8 * j; const LAS float* s = scr + (8 * c) * 33 + n;
        v4u o; o.x = pk2(s[0 * 33], s[1 * 33]); o.y = pk2(s[2 * 33], s[3 * 33]); o.z = pk2(s[4 * 33], s[5 * 33]); o.w = pk2(s[6 * 33], s[7 * 33]);
        *(v4u*)(WT + (size_t)(dst_row0 + n) * K + k0 + 8 * c) = o; }
    asm volatile("s_waitcnt lgkmcnt(0)" ::: "memory");
}
DI void convert_weights(const Args& a, int layer, LAS unsigned char* lds, int gw, int NGW, int wave, int lane) {
    LAS float* scr = (LAS float*)(lds + wave * 16384);
    const int kind = layer % 3, j = layer / 3;
    const int NQ = kind == 0 ? 3072 : 1536;
    const float* wqkv = kind == 0 ? a.a_w_qkv + (size_t)j * DM * 3072 : (kind == 1 ? a.b_w_qkv : a.c_w_qkv) + (size_t)j * DM * 1536;
    const float* wo = (kind == 0 ? a.a_w_o : (kind == 1 ? a.b_w_o : a.c_w_o)) + (size_t)j * DM * DM;
    const float* wup = a.ffn_w_up + (size_t)layer * DM * NUP;
    const float* wdn = a.ffn_w_down + (size_t)layer * DFF * DM;
    bf16* Wqkv_t = (bf16*)(a.ws + WS_WQKV); bf16* Wo_t = (bf16*)(a.ws + WS_WO); bf16* Wup_t = (bf16*)(a.ws + WS_WUP); bf16* Wdn_t = (bf16*)(a.ws + WS_WDN);
    const int I_Q = (DM / 64) * (NQ / 32), I_O = (DM / 64) * (DM / 32), I_U = (DM / 64) * (NUP / 32), I_D = (DFF / 64) * (DM / 32);
    for (int it = gw; it < I_Q + I_O + I_U + I_D; it += NGW) {
        int r = it;
        if (r < I_Q) { const int nb = r % (NQ / 32), kb = r / (NQ / 32), tile = nb >> 3, bc = nb & 7;
            transpose_item(wqkv, DM, NQ, Wqkv_t, 64 * kb, 32 * nb, 256 * tile + 32 * (4 * (bc & 1) + (bc >> 1)), scr, lane); continue; }
        r -= I_Q;
        if (r < I_O) { const int nb = r % (DM / 32), kb = r / (DM / 32); transpose_item(wo, DM, DM, Wo_t, 64 * kb, 32 * nb, 32 * nb, scr, lane); continue; }
        r -= I_O;
        if (r < I_U) { const int nb = r % (NUP / 32), kb = r / (NUP / 32); const int n0 = 32 * nb, bj = n0 >= DFF ? 1 : 0, ch = n0 - bj * DFF;
            transpose_item(wup, DM, NUP, Wup_t, 64 * kb, n0, 256 * (ch >> 7) + 128 * bj + (ch & 127), scr, lane); continue; }
        r -= I_U;
        { const int nb = r % (DM / 32), kb = r / (DM / 32); transpose_item(wdn, DFF, DM, Wdn_t, 64 * kb, 32 * nb, 32 * nb, scr, lane); }
    }
}
DI void prologue(const Args& a, LAS unsigned char* lds, int tid, int wave, int lane, int G) {
    float* MOD = (float*)(a.ws + WS_MOD);
    LAS float* scl = (LAS float*)lds;
    LAS float* red = (LAS float*)(lds + 17 * 1024 * 4);
    for (int idx = tid; idx < NMODB * DM; idx += NTHREADS) { const int bb = idx >> 10, k = idx & 1023; const float v = bb < NBATCH ? a.c[bb * DM + k] : a.c_ctx[k]; scl[idx] = v / (1.f + expf(-v)); }
    __syncthreads();
#pragma unroll 1
    for (int task = blockIdx.x; task < DEPTH * (MODW / 64); task += G) {
        const int layer = task / (MODW / 64), n0 = (task % (MODW / 64)) * 64;
        const float* W = a.adaln_w + (size_t)layer * DM * MODW + n0 + lane;
        float acc[NMODB];
#pragma unroll
        for (int bb = 0; bb < NMODB; ++bb) acc[bb] = 0.f;
#pragma unroll 1
        for (int kk0 = 0; kk0 < 128; kk0 += 16) { float wv[16];
#pragma unroll
            for (int i = 0; i < 16; ++i) wv[i] = W[(size_t)(128 * wave + kk0 + i) * MODW];
#pragma unroll
            for (int i = 0; i < 16; ++i) { const int k = 128 * wave + kk0 + i;
#pragma unroll
                for (int bb = 0; bb < NMODB; ++bb) acc[bb] += scl[bb * DM + k] * wv[i]; } }
#pragma unroll
        for (int bb = 0; bb < NMODB; ++bb) red[(wave * NMODB + bb) * 64 + lane] = acc[bb];
        __syncthreads();
        for (int o = tid; o < NMODB * 64; o += NTHREADS) { const int bb = o >> 6, ln = o & 63; float s = a.adaln_b[layer * MODW + n0 + ln];
#pragma unroll
            for (int w8 = 0; w8 < 8; ++w8) s += red[(w8 * NMODB + bb) * 64 + ln];
            MOD[((size_t)layer * NMODB + bb) * MODW + n0 + ln] = s; }
        __syncthreads();
    }
    float* rcos = (float*)(a.ws + WS_ROPE); float* rsin = rcos + SEQL * 32;
    for (int idx = blockIdx.x * NTHREADS + tid; idx < SEQL * 32; idx += G * NTHREADS) { const int t = idx >> 5, jj = idx & 31, f = jj & 15; const float pos = (float)(jj < 16 ? (t >> 6) : (t & 63));
        const float inv = exp2f(-(float)f * (13.287712379549449f / 16.f)); const float ang = pos * inv; rcos[idx] = cosf(ang); rsin[idx] = sinf(ang); }
    __syncthreads();
    convert_weights(a, 0, lds, blockIdx.x * NWAVES + wave, G * NWAVES, wave, lane);
}
DI void norm_pass(const Args& a, int layer, int which, int nrows, int gw, int NGW, int lane) {
    const float* MOD = (const float*)(a.ws + WS_MOD) + (size_t)layer * NMODB * MODW;
    const bf16* Xb = (const bf16*)(a.ws + WS_X); bf16* HN = (bf16*)(a.ws + WS_HN);
    const float* g = (which == 1 ? a.norm1_g : a.norm2_g) + layer * DM;
    const int sh_off = which == 1 ? 0 : 3 * DM, sc_off = which == 1 ? DM : 4 * DM;
    const bool from_input = (layer == 0 && which == 1);
    const int R = (nrows + NGW - 1) / NGW, r0 = gw * R, r1 = (r0 + R < nrows) ? r0 + R : nrows;
    int cur_bb = -1; f32x4 gs[2][2], sh[2][2];
#pragma unroll
    for (int j = 0; j < 2; ++j)
#pragma unroll
        for (int k = 0; k < 2; ++k) { gs[j][k] = (f32x4){0.f, 0.f, 0.f, 0.f}; sh[j][k] = gs[j][k]; }
    for (int row = r0; row < r1; ++row) {
        const int bb = row < MLAT ? row >> 11 : NBATCH;
        f32x4 v[2][2]; float s = 0.f;
        if (from_input) { const float* src = row < MLAT ? a.x + (size_t)row * DM : a.ctx + (size_t)(row - MLAT) * DM;
#pragma unroll
            for (int j = 0; j < 2; ++j)
#pragma unroll
                for (int k = 0; k < 2; ++k) v[j][k] = *(const f32x4*)(src + 8 * (lane + 64 * j) + 4 * k); }
        else { const v4u* xr = (const v4u*)(Xb + (size_t)row * DM) + lane;
#pragma unroll
            for (int j = 0; j < 2; ++j) { const v4u r4 = xr[64 * j]; v[j][0] = (f32x4){bf_lo(r4.x), bf_hi(r4.x), bf_lo(r4.y), bf_hi(r4.y)}; v[j][1] = (f32x4){bf_lo(r4.z), bf_hi(r4.z), bf_lo(r4.w), bf_hi(r4.w)}; } }
        if (bb != cur_bb) { cur_bb = bb;
            const float* scp = MOD + (size_t)bb * MODW + sc_off; const float* shp = MOD + (size_t)bb * MODW + sh_off;
#pragma unroll
            for (int j = 0; j < 2; ++j)
#pragma unroll
                for (int k = 0; k < 2; ++k) { const int c = 8 * (lane + 64 * j) + 4 * k; gs[j][k] = *(const f32x4*)(g + c) * (*(const f32x4*)(scp + c) + 1.f); sh[j][k] = *(const f32x4*)(shp + c); } }
#pragma unroll
        for (int j = 0; j < 2; ++j)
#pragma unroll
            for (int k = 0; k < 2; ++k) s += (v[j][k].x * v[j][k].x + v[j][k].y * v[j][k].y) + (v[j][k].z * v[j][k].z + v[j][k].w * v[j][k].w);
        const float rstd = 1.f / sqrtf(wave_sum(s) * (1.f / DM) + EPSN);
        v4u* o16 = (v4u*)(HN + (size_t)row * DM) + lane;
#pragma unroll
        for (int j = 0; j < 2; ++j) { const f32x4 y0 = v[j][0] * rstd * gs[j][0] + sh[j][0], y1 = v[j][1] * rstd * gs[j][1] + sh[j][1];
            v4u w; w.x = pk2(y0.x, y0.y); w.y = pk2(y0.z, y0.w); w.z = pk2(y1.x, y1.y); w.w = pk2(y1.z, y1.w); o16[64 * j] = w; }
    }
}
DI void conv_fixup(const Args& a, int layer, int ntiles, int gt, int GT) {
    const float* HB = (const float*)(a.ws + WS_HB); bf16* ACT = (bf16*)(a.ws + WS_QKV);
    const float* cw = a.ffn_conv_w + (size_t)layer * 3 * NUP; const float* cb = a.ffn_conv_b + (size_t)layer * NUP;
    for (int idx = gt; idx < ntiles * 2 * (DFF / 4); idx += GT) {
        const int ch = (idx % (DFF / 4)) * 4, pe = idx / (DFF / 4), edge = pe & 1, pm = pe >> 1;
        const bool lat = pm < MLAT / 256; const bool start = lat ? (pm & 7) == 0 : true, end = lat ? (pm & 7) == 7 : true;
        const float* hb = HB + (size_t)pm * 4 * NUP;
        f32x4 cv[2];
#pragma unroll
        for (int hf = 0; hf < 2; ++hf) { const int col = hf * DFF + ch; f32x4 up, uc, un; const f32x4 z = (f32x4){0.f, 0.f, 0.f, 0.f};
            if (edge == 0) { up = start ? z : *(const f32x4*)(hb - NUP + col); uc = *(const f32x4*)(hb + col); un = *(const f32x4*)(hb + NUP + col); }
            else { up = *(const f32x4*)(hb + 2 * NUP + col); uc = *(const f32x4*)(hb + 3 * NUP + col); un = end ? z : *(const f32x4*)(hb + 4 * NUP + col); }
            cv[hf] = *(const f32x4*)(cw + col) * up + *(const f32x4*)(cw + NUP + col) * uc + *(const f32x4*)(cw + 2 * NUP + col) * un + *(const f32x4*)(cb + col); }
        uint2 w; w.x = pk2(silu_f(cv[0].x) * cv[1].x, silu_f(cv[0].y) * cv[1].y); w.y = pk2(silu_f(cv[0].z) * cv[1].z, silu_f(cv[0].w) * cv[1].w);
        *(uint2*)(ACT + (size_t)(256 * pm + (edge ? 255 : 0)) * DFF + ch) = w;
    }
}

DI unsigned char* ws_opaque(unsigned char* p) { asm volatile("" : "+s"(p)); return p; }
#define WSB ws_opaque(a.ws)
#define MODp ((float*)(WSB + WS_MOD))
#define rcos ((const float*)(WSB + WS_ROPE))
#define rsin ((const float*)(WSB + WS_ROPE) + SEQL * 32)
#define X ((bf16*)(WSB + WS_X))
#define HN ((bf16*)(WSB + WS_HN))
#define QKV ((bf16*)(WSB + WS_QKV))
#define ACT ((bf16*)(WSB + WS_QKV))
#define HB ((float*)(WSB + WS_HB))
#define Wqkv_t ((bf16*)(WSB + WS_WQKV))
#define Wo_t ((bf16*)(WSB + WS_WO))
#define Wup_t ((bf16*)(WSB + WS_WUP))
#define Wdn_t ((bf16*)(WSB + WS_WDN))
__global__ void __launch_bounds__(NTHREADS, 2) fwd_mega(Args a) {
    extern __shared__ __attribute__((aligned(16))) unsigned char lds_raw[];
    LAS unsigned char* lds = (LAS unsigned char*)lds_raw;
    cg::grid_group grid = cg::this_grid();
    const int G = gridDim.x, bx = blockIdx.x;
    const int wave0 = __builtin_amdgcn_readfirstlane((int)threadIdx.x >> 6);
    const int vb = (G % 8 == 0) ? (bx % 8) * (G / 8) + bx / 8 : bx;
    const int NGW = G * NWAVES, GT = G * NTHREADS;
#define PHASE_IDS() int tid = wave0 * 64 + lane_id_opaque(); asm volatile("" : "+v"(tid)); const int lane = tid & 63, wave = __builtin_amdgcn_readfirstlane(tid >> 6), gw = bx * NWAVES + wave, gt = bx * NTHREADS + tid; (void)lane; (void)wave; (void)gw; (void)gt

    if (threadIdx.x < 16) ((LAS unsigned*)(lds + MISC_OFF))[threadIdx.x] = 0u;
    __syncthreads();
    const XcdBarrier xbar = xcd_barrier_post((unsigned*)(a.ws + WS_CTL), (volatile LAS unsigned*)(lds + MISC_OFF));
    if (PHM & 1) { PHASE_IDS(); prologue(a, lds, tid, wave, lane, G); }
    grid.sync();
#pragma unroll 1
    for (int layer = 0; layer < DEPTH; ++layer) {
        const int kind = layer % 3, j = layer / 3; const bool last = layer == DEPTH - 1;
        const int NQ = kind == 0 ? 3072 : 1536, MR = last ? MLAT : MTOT;
        const float* MODl = MODp + (size_t)layer * NMODB * MODW;
        if (PHM & 2) { PHASE_IDS(); if (layer > 0) { __syncthreads(); convert_weights(a, layer, lds, gw, NGW, wave, lane); }
            for (int xn_ = 0; xn_ < X_NORM; ++xn_) norm_pass(a, layer, 1, MTOT, gw, NGW, lane); }
        GSYNC();
        for (int xq_ = 0; xq_ < X_QKV; ++xq_)
        if (PHM & 4) { pg8::Gemm g{HN, Wqkv_t, MTOT, NQ, DM}; pg8::StaticOrder S; S.init(MTOT, NQ, G, bx);
          const float* qkg = (kind == 0 ? a.a_qk_g : (kind == 1 ? a.b_qk_g : a.c_qk_g)) + j * 128;
          pg8::EpiQKV E{QKV, NQ, qkg, qkg + 64, rcos, rsin, 4, kind == 0 ? 4 : 1};
          pg8::gemm_phase<pg8::EpiQKV, pg8::StaticOrder, true, true>(lds, g, S, E, wave0); }
        GSYNC();
        for (int xa_ = 0; xa_ < X_ATT; ++xa_)
        if (!(PHM & 8)) {} else if (kind == 0) att::attn_phase<0>(lds, QKV, NQ, HN, a.a_lambda + j * 256, a.a_head_g + j * 128, 0.8f - 0.6f * expf(-0.3f * (float)layer), nullptr, !last, vb, G, wave0);
        else if (kind == 1 && (PHM & 16)) att::attn_phase<1>(lds, QKV, NQ, HN, nullptr, nullptr, 0.f, nullptr, !last, vb, G, wave0);
        else if (PHM & 32) att::attn_phase<2>(lds, QKV, NQ, HN, nullptr, nullptr, 0.f, a.c_sink + j * 16, !last, vb, G, wave0);
        GSYNC();
        if (PHM & 64) { pg8::Gemm g{HN, Wo_t, MR, DM, DM}; pg8::StaticOrder S; S.init(MR, DM, G, bx);
          pg8::EpiResid E{a.x, a.ctx - (size_t)MLAT * DM, layer == 0 ? (const bf16*)nullptr : (const bf16*)X, X, (float*)nullptr, MODl + 2 * DM};
          pg8::gemm_phase<pg8::EpiResid, pg8::StaticOrder, true, true>(lds, g, S, E, wave0); }
        GSYNC();
        if (PHM & 128) { PHASE_IDS(); for (int xn_ = 0; xn_ < X_NORM; ++xn_) norm_pass(a, layer, 2, MR, gw, NGW, lane); }
        GSYNC();
        for (int xu_ = 0; xu_ < X_UP; ++xu_)
        if (PHM & 256) { pg8::Gemm g{HN, Wup_t, MR, NUP, DM}; pg8::StaticOrder S; S.init(MR, NUP, G, bx);
          pg8::EpiConv E{ACT, HB, a.ffn_conv_w + (size_t)layer * 3 * NUP, a.ffn_conv_b + (size_t)layer * NUP};
          pg8::gemm_phase<pg8::EpiConv, pg8::StaticOrder, true, true>(lds, g, S, E, wave0); }
        GSYNC();
        if (PHM & 512) { PHASE_IDS(); conv_fixup(a, layer, MR / 256, gt, GT); }
        GSYNC();
        if (PHM & 1024) { pg8::Gemm g{ACT, Wdn_t, MR, DM, DFF}; pg8::StaticOrder S; S.init(MR, DM, G, bx);
          pg8::EpiResid E{a.x, a.ctx, (const bf16*)X, X, last ? a.out : (float*)nullptr, MODl + 5 * DM};
          pg8::gemm_phase<pg8::EpiResid, pg8::StaticOrder, true, true>(lds, g, S, E, wave0); }
        if (!last) GSYNC();
    }
}

extern "C" void kernel_launch(void* const* d_in, const int* in_sizes, int n_in, void* d_out, int out_size, void* d_ws, size_t ws_size, hipStream_t stream) {
    static int grid = 0;
    if (grid == 0) {
        int dev = 0, cus = 0, per_cu = 0;
        if (n_in != 24 || out_size != MLAT * DM || ws_size < WS_END) { fprintf(stderr, "kernel_launch: unexpected shapes n_in %d out %d ws %zu\n", n_in, out_size, ws_size); grid = -1; return; }
        (void)hipGetDevice(&dev); (void)hipDeviceGetAttribute(&cus, hipDeviceAttributeMultiprocessorCount, dev);
        (void)hipFuncSetAttribute((const void*)fwd_mega, hipFuncAttributeMaxDynamicSharedMemorySize, LDS_BYTES);
        (void)hipOccupancyMaxActiveBlocksPerMultiprocessor(&per_cu, (const void*)fwd_mega, NTHREADS, LDS_BYTES);
        if (per_cu < 1) per_cu = 1;
        grid = cus * per_cu;
        fprintf(stderr, "kernel_launch: cus %d per_cu %d grid %d ws %zu\n", cus, per_cu, grid, ws_size);
    }
    if (grid < 0) return;
    if (hipMemsetAsync((char*)d_ws + WS_CTL, 0, CTL_ZERO_BYTES, stream) != hipSuccess) { fprintf(stderr, "kernel_launch: memset failed\n"); return; }
    Args a{};
    const float** ap = (const float**)&a;
    for (int i = 0; i < 24; ++i) ap[i] = (const float*)d_in[i];
    a.out = (float*)d_out; a.ws = (unsigned char*)d_ws;
    void* args[] = {&a};
    hipError_t e = hipLaunchCooperativeKernel((const void*)fwd_mega, dim3(grid), dim3(NTHREADS), args, LDS_BYTES, stream);
    if (e != hipSuccess) fprintf(stderr, "cooperative launch failed: %s (grid %d)\n", hipGetErrorString(e), grid);
}
```

```cpp
#include <hip/hip_runtime.h>
#include <hip/hip_cooperative_groups.h>
#include <cstdio>
#include <cstdint>
namespace cg = cooperative_groups;
#define LAS __attribute__((address_space(3)))
#define DI __device__ __forceinline__
constexpr int DM = 1024, NBATCH = 16, SEQL = 2048, CTXL = 256, DEPTH = 4;
constexpr int MLAT = NBATCH * SEQL, MCTX = NBATCH * CTXL, MTOT = MLAT + MCTX;
constexpr int DFF = 2816, NUP = 2 * DFF, MODW = 6 * DM, NMODB = NBATCH + 1;
constexpr float EPSN = 1e-6f;
constexpr float QSCALE = 0.125f * 1.4426950408889634f;
typedef float f32x2_t __attribute__((ext_vector_type(2)));
typedef __bf16 bf16x2_t __attribute__((ext_vector_type(2)));
DI unsigned pk2(float lo, float hi) { f32x2_t v = {lo, hi}; bf16x2_t b = __builtin_convertvector(v, bf16x2_t); return __builtin_bit_cast(unsigned, b); }
DI float bf_lo(unsigned u) { return __uint_as_float(u << 16); }
DI float bf_hi(unsigned u) { return __uint_as_float(u & 0xffff0000u); }
DI float silu_f(float g) { return g * __builtin_amdgcn_rcpf(1.f + __builtin_amdgcn_exp2f(-1.4426950408889634f * g)); }
DI int lane_id_opaque() { int l; asm volatile("v_mbcnt_lo_u32_b32 %0, -1, 0\n\tv_mbcnt_hi_u32_b32 %0, -1, %0" : "=v"(l)); return l; }
namespace pg8 {
#define PG8_LAS __attribute__((address_space(3)))
typedef unsigned short bf16_t;
typedef short bf16x8 __attribute__((ext_vector_type(8)));
typedef float f32x4 __attribute__((ext_vector_type(4)));
typedef unsigned u32x4 __attribute__((ext_vector_type(4)));
constexpr int BM = 256, BK = 64, HALF = 128, HTB = HALF * BK * 2  , STAGE_BYTES = 8 * HTB, NXCD = 8, WGM = 8;

__host__ __device__ __forceinline__ int lds_byte(int r, int c) { const int st = (r >> 4) * 2 + (c >> 5), rr = r & 15, cc = c & 31, ob = rr * 64 + cc * 2; return st * 1024 + (ob ^ (((ob >> 9) & 1) << 5)); }
__host__ __device__ __forceinline__ void stage_rc(int b, int& R, int& C) { const int st = b / 1024, sb = b % 1024, swz = sb ^ (((sb >> 9) & 1) << 5); R = (st >> 1) * 16 + swz / 64; C = (st & 1) * 32 + (swz % 64) / 2; }
__host__ __device__ __forceinline__ int perm32(int rho) { const int n = rho >> 4, i = rho & 15; return 8 * (i >> 2) + 4 * n + (i & 3); }

struct Unit { int pm, pn; };
struct Gemm { const bf16_t* A; const bf16_t* Bt; int M, N, K; };

struct StaticOrder {
    int nM, nN, nwg, G, c;
    __host__ __device__ void init(int M, int N, int G_, int c_) { nM = M / BM; nN = N / BM; nwg = nM * nN; G = G_; c = c_; }
    __host__ __device__ bool next(int i, Unit& u) const {
        const long L = (long)i * G + c; if (L >= nwg) return false;
        int wgid = (int)L; { const int q = nwg / NXCD, r = nwg % NXCD, xcd = wgid % NXCD, off = wgid / NXCD; wgid = (xcd < r ? xcd * (q + 1) : r * (q + 1) + (xcd - r) * q) + off; }
        const int nig = WGM * nN, gid = wgid / nig, fm = gid * WGM, gsz = (nM - fm) < WGM ? (nM - fm) : WGM;
        u.pm = fm + ((wgid % nig) % gsz); u.pn = (wgid % nig) / gsz; return true;
    }
    __device__ __forceinline__ void a_ready(const Unit&) const {}
    __device__ __forceinline__ void done(const Unit&) const {}
};

struct EpiQKV {
    static constexpr bool PERM = true, AFTER_DRAIN = false;
    bf16_t* O; int ldc; const float* qg; const float* kg; const float* rcos; const float* rsin; int nq_tiles, nk_tiles;
    __device__ __forceinline__ void operator()(const f32x4 (&acc)[2][2][4][2], const Unit& u, int wr, int wc, int fr, int fq, PG8_LAS unsigned char*) const {
        const int kind = u.pn < nq_tiles ? 0 : (u.pn < nq_tiles + nk_tiles ? 1 : 2);
        const int col0 = u.pn * BM + 64 * wc + 8 * fq;
        if (kind == 2) {
#pragma unroll
            for (int ai = 0; ai < 2; ++ai)
#pragma unroll
                for (int m = 0; m < 4; ++m) { bf16_t* rowp = O + (size_t)(u.pm * BM + ai * HALF + wr * 64 + m * 16 + fr) * ldc + col0;
#pragma unroll
                    for (int bj = 0; bj < 2; ++bj) { const f32x4 v0 = acc[ai][bj][m][0], v1 = acc[ai][bj][m][1]; u32x4 w; w.x = pk2(v0[0], v0[1]); w.y = pk2(v0[2], v0[3]); w.z = pk2(v1[0], v1[1]); w.w = pk2(v1[2], v1[3]);
                        *(u32x4*)(rowp + 32 * bj) = w; } }
            return;
        }
        const float* g = kind == 0 ? qg : kg; const float qs = kind == 0 ? QSCALE : 1.f;
        f32x4 g0[2], g1[2];
#pragma unroll
        for (int n = 0; n < 2; ++n) { g0[n] = *(const f32x4*)(g + 8 * fq + 4 * n); g1[n] = *(const f32x4*)(g + 32 + 8 * fq + 4 * n); }
#pragma unroll
        for (int ai = 0; ai < 2; ++ai)
#pragma unroll
            for (int m = 0; m < 4; ++m) {
                const int row = u.pm * BM + ai * HALF + wr * 64 + m * 16 + fr;
                float ss = 0.f;
#pragma unroll
                for (int bj = 0; bj < 2; ++bj)
#pragma unroll
                    for (int n = 0; n < 2; ++n) { const f32x4 x = acc[ai][bj][m][n]; ss += (x[0] * x[0] + x[1] * x[1]) + (x[2] * x[2] + x[3] * x[3]); }
                ss += __shfl_xor(ss, 16); ss += __shfl_xor(ss, 32);
                const float rstd = __builtin_amdgcn_rsqf(ss * (1.f / 64.f) + EPSN) * qs;
                f32x4 cs[2], sn[2];
                if (row < MLAT) { const int t = row & (SEQL - 1);
#pragma unroll
                    for (int n = 0; n < 2; ++n) { cs[n] = *(const f32x4*)(rcos + t * 32 + 8 * fq + 4 * n); sn[n] = *(const f32x4*)(rsin + t * 32 + 8 * fq + 4 * n); } }
                else { cs[0] = cs[1] = (f32x4){1.f, 1.f, 1.f, 1.f}; sn[0] = sn[1] = (f32x4){0.f, 0.f, 0.f, 0.f}; }
                f32x4 o1[2], o2[2];
#pragma unroll
                for (int n = 0; n < 2; ++n) { const f32x4 y1 = acc[ai][0][m][n] * rstd * g0[n], y2 = acc[ai][1][m][n] * rstd * g1[n]; o1[n] = y1 * cs[n] - y2 * sn[n]; o2[n] = y2 * cs[n] + y1 * sn[n]; }
                bf16_t* rowp = O + (size_t)row * ldc + col0;
                u32x4 w; w.x = pk2(o1[0][0], o1[0][1]); w.y = pk2(o1[0][2], o1[0][3]); w.z = pk2(o1[1][0], o1[1][1]); w.w = pk2(o1[1][2], o1[1][3]); *(u32x4*)rowp = w;
                w.x = pk2(o2[0][0], o2[0][1]); w.y = pk2(o2[0][2], o2[0][3]); w.z = pk2(o2[1][0], o2[1][1]); w.w = pk2(o2[1][2], o2[1][3]); *(u32x4*)(rowp + 32) = w;
            }
    }
};
struct EpiResid {
    static constexpr bool PERM = true, AFTER_DRAIN = false;
    const float* in_lat; const float* in_ctx; const bf16_t* in_bf; bf16_t* out_bf; float* out_f32; const float* gate;
    __device__ __forceinline__ void operator()(const f32x4 (&acc)[2][2][4][2], const Unit& u, int wr, int wc, int fr, int fq, PG8_LAS unsigned char*) const {
        asm volatile("" : "+v"(fr), "+v"(fq));
        const int col0 = u.pn * BM + wc * 32 + 8 * fq;
        const int bb = u.pm < MLAT / BM ? (u.pm >> 3) : NBATCH;
        const float* src = (const float*)((const char*)in_lat + (u.pm < MLAT / BM ? (long long)0 : (long long)((const char*)in_ctx - (const char*)in_lat)));
        f32x4 gv[2][2];
#pragma unroll
        for (int bj = 0; bj < 2; ++bj)
#pragma unroll
            for (int n = 0; n < 2; ++n) gv[bj][n] = *(const f32x4*)(gate + (size_t)bb * MODW + col0 + bj * HALF + n * 4);
        const size_t rowoff = (size_t)(u.pm * BM + wr * 64 + fr) * DM + col0;
        if (in_bf) {
#pragma unroll
            for (int ai = 0; ai < 2; ++ai) { u32x4 raw[4][2];
#pragma unroll
                for (int m = 0; m < 4; ++m)
#pragma unroll
                    for (int bj = 0; bj < 2; ++bj) raw[m][bj] = *(const u32x4*)(in_bf + rowoff + (size_t)(ai * HALF + m * 16) * DM + bj * HALF);
#pragma unroll
                for (int m = 0; m < 4; ++m)
#pragma unroll
                    for (int bj = 0; bj < 2; ++bj) { const u32x4 r = raw[m][bj]; const size_t off = rowoff + (size_t)(ai * HALF + m * 16) * DM + bj * HALF;
                        const f32x4 x0 = (f32x4){bf_lo(r.x), bf_hi(r.x), bf_lo(r.y), bf_hi(r.y)} + gv[bj][0] * acc[ai][bj][m][0];
                        const f32x4 x1 = (f32x4){bf_lo(r.z), bf_hi(r.z), bf_lo(r.w), bf_hi(r.w)} + gv[bj][1] * acc[ai][bj][m][1];
                        if (out_f32) { *(f32x4*)(out_f32 + off) = x0; *(f32x4*)(out_f32 + off + 4) = x1; }
                        else { u32x4 w; w.x = pk2(x0[0], x0[1]); w.y = pk2(x0[2], x0[3]); w.z = pk2(x1[0], x1[1]); w.w = pk2(x1[2], x1[3]); *(u32x4*)(out_bf + off) = w; } } }
        } else {
#pragma unroll
            for (int ai = 0; ai < 2; ++ai)
#pragma unroll
                for (int m = 0; m < 4; ++m) { const size_t off0 = rowoff + (size_t)(ai * HALF + m * 16) * DM; f32x4 xin[2][2];
#pragma unroll
                    for (int bj = 0; bj < 2; ++bj) { xin[bj][0] = *(const f32x4*)(src + off0 + bj * HALF); xin[bj][1] = *(const f32x4*)(src + off0 + bj * HALF + 4); }
#pragma unroll
                    for (int bj = 0; bj < 2; ++bj) { const f32x4 x0 = xin[bj][0] + gv[bj][0] * acc[ai][bj][m][0], x1 = xin[bj][1] + gv[bj][1] * acc[ai][bj][m][1];
                        u32x4 w; w.x = pk2(x0[0], x0[1]); w.y = pk2(x0[2], x0[3]); w.z = pk2(x1[0], x1[1]); w.w = pk2(x1[2], x1[3]); *(u32x4*)(out_bf + off0 + bj * HALF) = w; } }
        }
    }
};
DI float dpp_ror1(float x) { return __int_as_float(__builtin_amdgcn_update_dpp(0, __float_as_int(x), 0x121, 0xf, 0xf, false)); }
DI float dpp_ror15(float x) { return __int_as_float(__builtin_amdgcn_update_dpp(0, __float_as_int(x), 0x12F, 0xf, 0xf, false)); }
struct EpiConv {
    static constexpr bool PERM = true, AFTER_DRAIN = false;
    bf16_t* ACT; float* HB; const float* cw; const float* cb;
    __device__ __forceinline__ void operator()(const f32x4 (&acc)[2][2][4][2], const Unit& u, int wr, int wc, int fr, int fq, PG8_LAS unsigned char* lds) const {
        PG8_LAS float* H = (PG8_LAS float*)(lds + STAGE_BYTES);
        const int chl = 32 * wc + 8 * fq, lane = 16 * fq + fr;
        PG8_LAS float* CW = (PG8_LAS float*)(lds + STAGE_BYTES + 8192);
        const int tid_e = (wr * 4 + wc) * 64 + lane, arr_e = tid_e >> 7, p2_e = (tid_e & 127) * 2;
        typedef float f32x2e __attribute__((ext_vector_type(2)));
        const f32x2e cw2 = *(const f32x2e*)((arr_e < 3 ? cw + arr_e * NUP : cb) + (p2_e >> 7) * DFF + 128 * u.pn + (p2_e & 127));
#pragma unroll
        for (int ai = 0; ai < 2; ++ai) { const int seg = 2 * ai + wr;
            if (fr == 0) {
#pragma unroll
                for (int bj = 0; bj < 2; ++bj)
#pragma unroll
                    for (int n = 0; n < 2; ++n) *(PG8_LAS f32x4*)(H + ((seg * 2 + 0) * 2 + bj) * 128 + chl + 4 * n) = acc[ai][bj][0][n]; }
            if (fr == 15) {
#pragma unroll
                for (int bj = 0; bj < 2; ++bj)
#pragma unroll
                    for (int n = 0; n < 2; ++n) *(PG8_LAS f32x4*)(H + ((seg * 2 + 1) * 2 + bj) * 128 + chl + 4 * n) = acc[ai][bj][3][n]; } }
        if (wr == 0 && fr < 2) { float* hb = HB + ((size_t)u.pm * 4 + fr) * NUP + 128 * u.pn + chl;
#pragma unroll
            for (int bj = 0; bj < 2; ++bj)
#pragma unroll
                for (int n = 0; n < 2; ++n) *(f32x4*)(hb + bj * DFF + 4 * n) = acc[0][bj][0][n]; }
        if (wr == 1 && fr >= 14) { float* hb = HB + ((size_t)u.pm * 4 + (fr - 12)) * NUP + 128 * u.pn + chl;
#pragma unroll
            for (int bj = 0; bj < 2; ++bj)
#pragma unroll
                for (int n = 0; n < 2; ++n) *(f32x4*)(hb + bj * DFF + 4 * n) = acc[1][bj][3][n]; }
        *(PG8_LAS f32x2e*)(CW + arr_e * 256 + p2_e) = cw2;
        asm volatile("s_waitcnt lgkmcnt(0)" ::: "memory"); __builtin_amdgcn_s_barrier(); asm volatile("" ::: "memory");
#pragma unroll
        for (int n = 0; n < 2; ++n) {
            const int colg = 128 * u.pn + chl + 4 * n;
#pragma unroll
            for (int ai = 0; ai < 2; ++ai) { const int seg = 2 * ai + wr;
                f32x4 cg[4];
#pragma unroll
                for (int bj = 0; bj < 2; ++bj) {
                    const PG8_LAS float* cwl = CW + 128 * bj + chl + 4 * n;
                    const f32x4 w0 = *(const PG8_LAS f32x4*)cwl, w1 = *(const PG8_LAS f32x4*)(cwl + 256), w2 = *(const PG8_LAS f32x4*)(cwl + 512), bs = *(const PG8_LAS f32x4*)(cwl + 768);
                    f32x4 hp = (f32x4){0.f, 0.f, 0.f, 0.f}, hn = hp;
                    if (seg > 0) hp = *(const PG8_LAS f32x4*)(H + (((seg - 1) * 2 + 1) * 2 + bj) * 128 + chl + 4 * n);
                    if (seg < 3) hn = *(const PG8_LAS f32x4*)(H + (((seg + 1) * 2 + 0) * 2 + bj) * 128 + chl + 4 * n);
#pragma unroll
                    for (int e = 0; e < 4; ++e) {
                        float v[4], rr[4], rl[4]; const float w0e = w0[e], w1e = w1[e], w2e = w2[e], bse = bs[e];
#pragma unroll
                        for (int m = 0; m < 4; ++m) { v[m] = acc[ai][bj][m][n][e]; rr[m] = dpp_ror1(v[m]); rl[m] = dpp_ror15(v[m]); }
#pragma unroll
                        for (int m = 0; m < 4; ++m) {
                            const float pv = fr != 0 ? rr[m] : (m > 0 ? rr[m > 0 ? m - 1 : 0] : hp[e]);
                            const float nv = fr != 15 ? rl[m] : (m < 3 ? rl[m < 3 ? m + 1 : 3] : hn[e]);
                            const float cvv = w0e * pv + w1e * v[m] + w2e * nv + bse;
                            if (bj == 0) cg[m][e] = cvv; else cg[m][e] = silu_f(cg[m][e]) * cvv;
                        }
                    }
                }
#pragma unroll
                for (int m = 0; m < 4; ++m) { const int row = u.pm * BM + ai * HALF + wr * 64 + m * 16 + fr;
                    uint2 w; w.x = pk2(cg[m][0], cg[m][1]); w.y = pk2(cg[m][2], cg[m][3]);
                    *(uint2*)(ACT + (size_t)row * DFF + colg) = w; }
            }
        }
    }
};
template <class Epi, class Sched, bool ALIGN_EPI = false, bool SP2 = false>
__device__ __forceinline__ void gemm_phase(PG8_LAS unsigned char* lds, const Gemm g, const Sched& S, const Epi& E, const int wid0) {
    int tid_l = wid0 * 64 + lane_id_opaque(); asm volatile("" : "+v"(tid_l));
    const int tid = tid_l, wid = __builtin_amdgcn_readfirstlane(tid >> 6), lane = tid & 63, wr = wid >> 2, wc = wid & 3, fr = lane & 15, fq = lane >> 4;
    const int K = g.K, nt = K / BK;
    unsigned voffA[2], voffB[2];
#pragma unroll
    for (int i = 0; i < 2; ++i) { int R, C; stage_rc(tid * 16 + i * 8192, R, C); const int Rb = Epi::PERM ? ((R & ~31) + perm32(R & 31)) : R;
        voffA[i] = (unsigned)(R * K + C) * 2u; voffB[i] = (unsigned)(Rb * K + C) * 2u; }
    const size_t kstep = (size_t)(BK * 2);
    const size_t hstep = (size_t)HALF * K * 2;
    const size_t tstep = 2 * hstep;
    const unsigned ldsw = (unsigned)wid * 1024u;
    const int aoff = lds_byte(wr * 64 + fr, fq * 8), boff = lds_byte(wc * 32 + fr, fq * 8);
#define PG8_SA(b, h) (((b) * 2 + (h)) * HTB)
#define PG8_SB(b, h) ((4 + (b) * 2 + (h)) * HTB)
#define PG8_STAGE(bufoff, gbase, voff) do { _Pragma("unroll") for (int _i = 0; _i < 2; ++_i) \
        __builtin_amdgcn_global_load_lds((const unsigned*)((const char*)(gbase) + (voff)[_i]), (PG8_LAS unsigned*)(lds + (bufoff) + ldsw + _i * 8192), 16, 0, 0); } while (0)
#define PG8_LDA(dst, b, h) do { _Pragma("unroll") for (int m = 0; m < 4; ++m) _Pragma("unroll") for (int k = 0; k < 2; ++k) dst[m][k] = *(const PG8_LAS bf16x8*)(lds + PG8_SA(b, h) + aoff + m * 2048 + k * 1024); } while (0)
#define PG8_LDB(dst, b, h) do { _Pragma("unroll") for (int n = 0; n < 2; ++n) _Pragma("unroll") for (int k = 0; k < 2; ++k) dst[n][k] = *(const PG8_LAS bf16x8*)(lds + PG8_SB(b, h) + boff + n * 2048 + k * 1024); } while (0)
#define PG8_MMA(ai, bj, At, Bt) do { __builtin_amdgcn_s_setprio(1); _Pragma("unroll") for (int m = 0; m < 4; ++m) _Pragma("unroll") for (int n = 0; n < 2; ++n) _Pragma("unroll") for (int k = 0; k < 2; ++k) \
        acc[ai][bj][m][n] = __builtin_amdgcn_mfma_f32_16x16x32_bf16(Bt[n][k], At[m][k], acc[ai][bj][m][n], 0, 0, 0); __builtin_amdgcn_s_setprio(0); } while (0)
#define PG8_WAIT_V(n) asm volatile("s_waitcnt vmcnt(" #n ")" ::: "memory")
#define PG8_WAIT_L(n) asm volatile("s_waitcnt lgkmcnt(" #n ")" ::: "memory")
#define PG8_BAR __builtin_amdgcn_s_barrier()
#define PG8_SCHED __builtin_amdgcn_sched_barrier(0)
    Unit cur, nxt; int ui = 0;
    if (!S.next(0, cur)) return;
    f32x4 acc[2][2][4][2];
#pragma unroll
    for (int a = 0; a < 2; ++a)
#pragma unroll
        for (int b = 0; b < 2; ++b)
#pragma unroll
            for (int m = 0; m < 4; ++m)
#pragma unroll
                for (int n = 0; n < 2; ++n) acc[a][b][m][n] = (f32x4){0.f, 0.f, 0.f, 0.f};
    bf16x8 At[4][2], B0[2][2], B1[2][2];
    const char* cA = (const char*)g.A + (size_t)cur.pm * tstep; const char* cB = (const char*)g.Bt + (size_t)cur.pn * tstep;
    S.a_ready(cur);
    if constexpr (SP2) {
        PG8_STAGE(PG8_SB(0, 0), cB, voffB); PG8_STAGE(PG8_SB(0, 1), cB + hstep, voffB); PG8_STAGE(PG8_SA(0, 0), cA, voffA); PG8_STAGE(PG8_SA(0, 1), cA + hstep, voffA);
        if (wr == 1) PG8_BAR;
        PG8_WAIT_V(2); PG8_BAR;
        PG8_STAGE(PG8_SB(1, 0), cB + kstep, voffB); PG8_STAGE(PG8_SA(1, 0), cA + kstep, voffA); PG8_STAGE(PG8_SB(1, 1), cB + hstep + kstep, voffB);
        PG8_WAIT_V(6); PG8_BAR;
    } else {
        PG8_STAGE(PG8_SB(0, 0), cB, voffB); PG8_STAGE(PG8_SA(0, 0), cA, voffA); PG8_STAGE(PG8_SB(0, 1), cB + hstep, voffB); PG8_STAGE(PG8_SA(0, 1), cA + hstep, voffA);
        if (wr == 1) PG8_BAR;
        PG8_WAIT_V(4); PG8_BAR;
        PG8_STAGE(PG8_SB(1, 0), cB + kstep, voffB); PG8_STAGE(PG8_SA(1, 0), cA + kstep, voffA); PG8_STAGE(PG8_SB(1, 1), cB + hstep + kstep, voffB);
        PG8_WAIT_V(6); PG8_BAR;
    }
    for (;;) {
        const bool has_next = S.next(ui + 1, nxt);
        const char* nA = has_next ? (const char*)g.A + (size_t)nxt.pm * tstep : cA; const char* nB = has_next ? (const char*)g.Bt + (size_t)nxt.pn * tstep : cB;
        for (int t = 0; t < nt; t += 2) {
            const bool last = (t == nt - 2);
            const char* a1 = cA + (size_t)(t + 1) * kstep;
            const char* a2 = last ? nA : cA + (size_t)(t + 2) * kstep; const char* b2 = last ? nB : cB + (size_t)(t + 2) * kstep;
            const char* a3 = a2 + kstep; const char* b3 = b2 + kstep;
            if (last && has_next) S.a_ready(nxt);
            if constexpr (SP2) {
            PG8_LDB(B0, 0, 0); PG8_LDB(B1, 0, 1); PG8_SCHED; PG8_LDA(At, 0, 0); PG8_STAGE(PG8_SA(1, 1), a1 + hstep, voffA);
            PG8_WAIT_V(8); PG8_WAIT_L(0); PG8_BAR; PG8_MMA(0, 0, At, B0); PG8_MMA(0, 1, At, B1); PG8_BAR; PG8_SCHED;
            PG8_LDA(At, 0, 1); PG8_STAGE(PG8_SB(0, 0), b2, voffB); PG8_STAGE(PG8_SB(0, 1), b2 + hstep, voffB); PG8_STAGE(PG8_SA(0, 0), a2, voffA);
            PG8_WAIT_V(8); PG8_WAIT_L(0); PG8_BAR; PG8_MMA(1, 0, At, B0); PG8_MMA(1, 1, At, B1); PG8_BAR; PG8_SCHED;
            PG8_LDB(B0, 1, 0); PG8_LDB(B1, 1, 1); PG8_SCHED; PG8_LDA(At, 1, 0); PG8_STAGE(PG8_SA(0, 1), a2 + hstep, voffA);
            PG8_WAIT_V(8); PG8_WAIT_L(0); PG8_BAR; PG8_MMA(0, 0, At, B0); PG8_MMA(0, 1, At, B1); PG8_BAR; PG8_SCHED;
            PG8_LDA(At, 1, 1); PG8_STAGE(PG8_SB(1, 0), b3, voffB); PG8_STAGE(PG8_SB(1, 1), b3 + hstep, voffB); PG8_STAGE(PG8_SA(1, 0), a3, voffA);
            PG8_WAIT_V(8); PG8_WAIT_L(0); PG8_BAR; PG8_MMA(1, 0, At, B0); PG8_MMA(1, 1, At, B1); PG8_BAR; PG8_SCHED;
            } else {
            PG8_LDB(B0, 0, 0); PG8_SCHED; PG8_LDA(At, 0, 0); PG8_STAGE(PG8_SA(1, 1), a1 + hstep, voffA);
            PG8_WAIT_L(8); PG8_BAR; PG8_WAIT_L(0); PG8_MMA(0, 0, At, B0); PG8_BAR; PG8_SCHED;
            PG8_LDB(B1, 0, 1); PG8_STAGE(PG8_SB(0, 0), b2, voffB);
            PG8_BAR; PG8_WAIT_L(0); PG8_MMA(0, 1, At, B1); PG8_BAR;
            PG8_LDA(At, 0, 1); PG8_STAGE(PG8_SA(0, 0), a2, voffA);
            PG8_BAR; PG8_WAIT_L(0); PG8_MMA(1, 0, At, B0); PG8_BAR; PG8_SCHED;
            PG8_STAGE(PG8_SB(0, 1), b2 + hstep, voffB);
            PG8_WAIT_V(6); PG8_BAR; PG8_MMA(1, 1, At, B1); PG8_BAR;
            PG8_LDB(B0, 1, 0); PG8_SCHED; PG8_LDA(At, 1, 0); PG8_STAGE(PG8_SA(0, 1), a2 + hstep, voffA);
            PG8_WAIT_L(8); PG8_BAR; PG8_WAIT_L(0); PG8_MMA(0, 0, At, B0); PG8_BAR; PG8_SCHED;
            PG8_LDB(B1, 1, 1); PG8_STAGE(PG8_SB(1, 0), b3, voffB);
            PG8_BAR; PG8_WAIT_L(0); PG8_MMA(0, 1, At, B1); PG8_BAR;
            PG8_LDA(At, 1, 1); PG8_STAGE(PG8_SA(1, 0), a3, voffA);
            PG8_BAR; PG8_WAIT_L(0); PG8_MMA(1, 0, At, B0); PG8_BAR; PG8_SCHED;
            PG8_STAGE(PG8_SB(1, 1), b3 + hstep, voffB);
            PG8_WAIT_V(6); PG8_BAR; PG8_MMA(1, 1, At, B1); PG8_BAR;
            }
        }
        if constexpr (ALIGN_EPI) { if (wr == 0) PG8_BAR; }
        if constexpr (!Epi::AFTER_DRAIN) { E(acc, cur, wr, wc, fr, fq, lds); S.done(cur); }
        if (!has_next) break;
#pragma unroll
        for (int a = 0; a < 2; ++a)
#pragma unroll
            for (int b = 0; b < 2; ++b)
#pragma unroll
                for (int m = 0; m < 4; ++m)
#pragma unroll
                    for (int n = 0; n < 2; ++n) acc[a][b][m][n] = (f32x4){0.f, 0.f, 0.f, 0.f};
        cur = nxt; cA = nA; cB = nB; ++ui;
        if constexpr (ALIGN_EPI) { if (wr == 1) PG8_BAR; }
    }
    PG8_WAIT_V(0);
    if constexpr (!ALIGN_EPI) { if (wr == 0) PG8_BAR; }
    PG8_BAR;
    if constexpr (Epi::AFTER_DRAIN) { E.fused(acc, cur, wr, wc, fr, fq, lds, wid, lane); S.done(cur); }
#undef PG8_SA
#undef PG8_SB
#undef PG8_STAGE
#undef PG8_LDA
#undef PG8_LDB
#undef PG8_MMA
#undef PG8_WAIT_V
#undef PG8_WAIT_L
#undef PG8_BAR
#undef PG8_SCHED
}
}
namespace att {
typedef unsigned short bf16_t;
typedef short bf16x8 __attribute__((ext_vector_type(8)));
typedef short s16x4 __attribute__((ext_vector_type(4)));
typedef float f32x16 __attribute__((ext_vector_type(16)));
typedef float f32x4 __attribute__((ext_vector_type(4)));
typedef unsigned u32x4 __attribute__((ext_vector_type(4)));
constexpr int KP = 72;
constexpr int K_BYTES = 2 * 64 * KP * 2;
constexpr int V_BYTES = 3 * 64 * 160 * 2;
constexpr int SC_OFF = K_BYTES + V_BYTES, STASH_OFF = SC_OFF + 1024, ATT_LDS = STASH_OFF + 8 * 8192;
#define MFMA32(a, b, c) __builtin_amdgcn_mfma_f32_32x32x16_bf16((a), (b), (c), 0, 0, 0)
DI float max3f(float x, float y, float z) { return __builtin_fmaxf(__builtin_fmaxf(x, y), z); }
DI float halfmax(float v) { auto rr = __builtin_amdgcn_permlane32_swap(__float_as_uint(v), __float_as_uint(v), false, false); return __builtin_fmaxf(__uint_as_float(rr[0]), __uint_as_float(rr[1])); }
DI float halfsum(float v) { auto rr = __builtin_amdgcn_permlane32_swap(__float_as_uint(v), __float_as_uint(v), false, false); return __uint_as_float(rr[0]) + __uint_as_float(rr[1]); }
constexpr float THR = 8.f;
DI s16x4 vtr(const LAS bf16_t* p) { return __builtin_bit_cast(s16x4, __builtin_amdgcn_ds_read_tr16_b64_v4i16((LAS s16x4*)p)); }

template <int MODE>
DI void attn_phase(LAS unsigned char* lds, const bf16_t* __restrict__ QKV, const int ldq, bf16_t* __restrict__ O,
                   const float* lam_p, const float* head_g, const float lam_init, const float* sink, const bool need_ctx, const int vb, const int G, const int wid0) {
    constexpr int DV = MODE == 0 ? 128 : 64, DT = DV / 32, VP = DV == 64 ? 96 : 160  , NH = MODE == 0 ? 8 : 16, NPASS = MODE == 0 ? 2 : 1;
    int tid_l = wid0 * 64 + lane_id_opaque(); asm volatile("" : "+v"(tid_l));
    const int tid = tid_l, lane = tid & 63, r = lane & 31, h = lane >> 5, w = __builtin_amdgcn_readfirstlane(tid >> 6);
    const int i16 = lane & 15, q4 = i16 >> 2, p4 = i16 & 3, blk = (lane >> 4) & 1;
    LAS bf16_t* Ks = (LAS bf16_t*)lds; LAS bf16_t* Vs = (LAS bf16_t*)(lds + K_BYTES);
    LAS float* sc = (LAS float*)(lds + SC_OFF) + w * 32;
    LAS unsigned* stash = (LAS unsigned*)(lds + STASH_OFF) + w * 2048;
    const int lrow = tid >> 3, lch = tid & 7;
    float lam = 0.f;
    if (MODE == 0) { float a = lam_p[lane] * lam_p[64 + lane], b2 = lam_p[128 + lane] * lam_p[192 + lane];
#pragma unroll
        for (int o = 1; o < 64; o <<= 1) { a += __shfl_xor(a, o); b2 += __shfl_xor(b2, o); }
        lam = expf(a) - expf(b2) + lam_init; lam = __uint_as_float(__builtin_amdgcn_readfirstlane(__float_as_uint(lam))); }
    const int NLAT = NBATCH * NH * 8, NU = NLAT + (need_ctx ? NBATCH * NH : 0);
#pragma unroll 1
    for (int u = vb; u < NU; u += G) {
        int b, hd, qb; bool isctx = u >= NLAT;
        if (!isctx) { qb = u & 7; hd = (u >> 3) % NH; b = u / (8 * NH); } else { const int v = u - NLAT; qb = 0; hd = v % NH; b = v / NH; }
        const int qrow0 = isctx ? MLAT + b * CTXL : b * SEQL + 256 * qb;
        int t0 = 0, nl = 0;
        if (!isctx) { if (MODE == 2) { t0 = 4 * qb - 2 < 0 ? 0 : 4 * qb - 2; const int t1 = 4 * qb + 5 > 31 ? 31 : 4 * qb + 5; nl = t1 - t0 + 1; } else { nl = 32; } }
        const int nt = nl + 4;
        const int qw = 256 * qb + 32 * w;
        f32x16 o[DT];
#pragma unroll 1
        for (int pass = 0; pass < NPASS; ++pass) {
            const int qcol = MODE == 0 ? hd * 128 + pass * 64 : hd * 64;
            const int kcol = MODE == 0 ? 1024 + hd * 128 + pass * 64 : 1024 + (hd >> 2) * 64;
            const int vcol = MODE == 0 ? 2048 + hd * 128 : 1280 + (hd >> 2) * 64;
            bf16x8 qf[4];
            { const bf16_t* qp = QKV + (size_t)(qrow0 + 32 * w + r) * ldq + qcol + 8 * h;
#pragma unroll
              for (int s = 0; s < 4; ++s) qf[s] = *(const bf16x8*)(qp + 16 * s); }
            f32x16 negm;
#pragma unroll
            for (int i = 0; i < 16; ++i) negm[i] = 0.f;
            float m = 0.f, lsum = 0.f; bool valid = false;
#pragma unroll
            for (int dt = 0; dt < DT; ++dt)
#pragma unroll
                for (int i = 0; i < 16; ++i) o[dt][i] = 0.f;
            __syncthreads();
            const LAS bf16_t* klane = Ks + r * KP + 8 * h; const LAS bf16_t* vlane = Vs + (4 * h + q4) * VP + 16 * blk + 4 * p4;
            constexpr int PD = 3, NLD = 1 + DT / 2;
            u32x4 kq[PD], vq[PD][DT / 2];
#define TILE_ROW(tt) ((tt) < nl ? b * SEQL + 64 * (t0 + (tt)) : MLAT + b * CTXL + 64 * ((tt) - nl))
#define GLOAD16(dst, ptr) asm volatile("global_load_dwordx4 %0, %1, off" : "=v"(dst) : "v"(ptr) : "memory")
#define LOAD_TILE(pi_, tt) do { const bf16_t* gp_ = QKV + (size_t)(TILE_ROW(tt) + lrow) * ldq; GLOAD16(kq[pi_], gp_ + kcol + 8 * lch); \
            _Pragma("unroll") for (int j_ = 0; j_ < DT / 2; ++j_) GLOAD16(vq[pi_][j_], gp_ + vcol + 8 * lch + 64 * j_); } while (0)
            asm volatile("" :: "v"(qf[0]), "v"(qf[1]), "v"(qf[2]), "v"(qf[3]));
#pragma unroll
            for (int pi = 0; pi < PD; ++pi) LOAD_TILE(pi, pi);
#pragma unroll 1
            for (int tb = 0; tb < nt; tb += PD) {
#pragma unroll
              for (int pi = 0; pi < PD; ++pi) { const int t = tb + pi; if (t < nt) {
                const int buf = t & 1, vslot = t % 3;
                if (PD == 3 && t + 2 < nt) { if (NLD == 2) asm volatile("s_waitcnt vmcnt(4)" ::: "memory"); else asm volatile("s_waitcnt vmcnt(6)" ::: "memory"); }
                else if (t + 1 < nt) { if (NLD == 2) asm volatile("s_waitcnt vmcnt(2)" ::: "memory"); else asm volatile("s_waitcnt vmcnt(3)" ::: "memory"); }
                else asm volatile("s_waitcnt vmcnt(0)" ::: "memory");
                asm volatile("" : "+v"(kq[pi]));
#pragma unroll
                for (int j = 0; j < DT / 2; ++j) asm volatile("" : "+v"(vq[pi][j]));
                *(LAS u32x4*)(Ks + (buf * 64 + lrow) * KP + 8 * lch) = kq[pi];
#pragma unroll
                for (int j = 0; j < DT / 2; ++j) *(LAS u32x4*)(Vs + (vslot * 64 + lrow) * VP + 8 * lch + 64 * j) = vq[pi][j];
                asm volatile("s_waitcnt lgkmcnt(0)\n\ts_barrier" ::: "memory");
                if (t + PD < nt) LOAD_TILE(pi, t + PD);
                const bool lat_tile = t < nl; const int kpos0 = 64 * (t0 + t);
                bool skip = false, domask = false;
                if (MODE == 2 && lat_tile) { skip = (kpos0 > qw + 31 + 128) || (kpos0 + 63 < qw - 128); domask = !((kpos0 + 63 <= qw + 128) && (kpos0 >= qw + 31 - 128)); }
                if (!skip) {
                    const LAS bf16_t* Kt = klane + buf * 64 * KP; const LAS bf16_t* Vt = vlane + vslot * 64 * VP;
                    f32x16 pA, pB;
                    bf16x8 kfA[4], kfB[4], vf[2][DT];
#define VFRAG_LOAD(dst, HH) do { _Pragma("unroll") for (int kk_ = 0; kk_ < 2; ++kk_) _Pragma("unroll") for (int dt_ = 0; dt_ < DT; ++dt_) { \
                        const LAS bf16_t* vp_ = Vt + (16 * (2 * (HH) + kk_) * VP + 32 * dt_); const s16x4 lo_ = vtr(vp_), hi_ = vtr(vp_ + 8 * VP); \
                        dst[kk_][dt_] = __builtin_shufflevector(lo_, hi_, 0, 1, 2, 3, 4, 5, 6, 7); } } while (0)
                    if constexpr (MODE != 0) {
#pragma unroll
                        for (int s = 0; s < 4; ++s) { kfA[s] = *(const LAS bf16x8*)(Kt + 16 * s); kfB[s] = *(const LAS bf16x8*)(Kt + (32 * KP + 16 * s)); }
                        __builtin_amdgcn_sched_barrier(0);
#pragma unroll
                        for (int s = 0; s < 4; ++s) { if (s == 0) { pA = MFMA32(kfA[0], qf[0], negm); pB = MFMA32(kfB[0], qf[0], negm); } else { pA = MFMA32(kfA[s], qf[s], pA); pB = MFMA32(kfB[s], qf[s], pB); } }
                    } else {
#pragma unroll
                        for (int s = 0; s < 4; ++s) kfA[s] = *(const LAS bf16x8*)(Kt + 16 * s);
                        __builtin_amdgcn_sched_barrier(0);
#pragma unroll
                        for (int s = 0; s < 4; ++s) { if (s == 0) pA = MFMA32(kfA[0], qf[0], negm); else pA = MFMA32(kfA[s], qf[s], pA); }
                    }
                    if (MODE == 2 && domask) { const int qpos = qw + r;
#pragma unroll
                        for (int i = 0; i < 16; ++i) { const int d0 = kpos0 + (i & 3) + 8 * (i >> 2) + 4 * h - qpos;
                            if (d0 > 128 || d0 < -128) pA[i] = -INFINITY;
                            if (d0 + 32 > 128 || d0 + 32 < -128) pB[i] = -INFINITY; } }
#define VKK_LOAD(dst, KS) do { _Pragma("unroll") for (int dt_ = 0; dt_ < DT; ++dt_) { const LAS bf16_t* vp_ = Vt + (16 * (KS) * VP + 32 * dt_); const s16x4 lo_ = vtr(vp_), hi_ = vtr(vp_ + 8 * VP); \
                        dst[dt_] = __builtin_shufflevector(lo_, hi_, 0, 1, 2, 3, 4, 5, 6, 7); } } while (0)
#define HALF_STEP(P, HH, OTHER_FIX) do { \
                    if constexpr (MODE != 0) { VFRAG_LOAD(vf, HH); __builtin_amdgcn_sched_barrier(0); }     \
                    else { VKK_LOAD(vf[0], 2 * (HH)); __builtin_amdgcn_sched_barrier(0); }                 \
                    float mt_; \
                    { float xa_ = max3f(P[0], P[1], P[2]), xb_ = max3f(P[3], P[4], P[5]); \
                      xa_ = max3f(xa_, P[6], P[7]); xb_ = max3f(xb_, P[8], P[9]); xa_ = max3f(xa_, P[10], P[11]); xb_ = max3f(xb_, P[12], P[13]); xa_ = max3f(xa_, P[14], P[15]); \
                      mt_ = halfmax(__builtin_fmaxf(xa_, xb_)); } \
                    const bool upd_ = valid ? (mt_ > THR) : (mt_ > -INFINITY); \
                    if (__any(upd_)) { \
                        const float dl = upd_ ? mt_ : 0.f; \
                        const float alpha_ = valid ? __builtin_amdgcn_exp2f(-dl) : 1.f; \
                        m += dl; valid = valid || upd_; \
                        _Pragma("unroll") for (int i_ = 0; i_ < 16; ++i_) negm[i_] = -m; \
                        _Pragma("unroll") for (int i_ = 0; i_ < 16; ++i_) P[i_] -= dl; \
                        OTHER_FIX; \
                        lsum *= alpha_; \
                        if (h == 0) sc[r] = alpha_; \
                        asm volatile("s_waitcnt lgkmcnt(0)" ::: "memory"); \
                        _Pragma("unroll") for (int g_ = 0; g_ < 4; ++g_) { const f32x4 a4_ = *(const LAS f32x4*)(sc + 8 * g_ + 4 * h); \
                            _Pragma("unroll") for (int dt_ = 0; dt_ < DT; ++dt_) \
                                _Pragma("unroll") for (int j_ = 0; j_ < 4; ++j_) o[dt_][4 * g_ + j_] *= a4_[j_]; } \
                        asm volatile("s_waitcnt lgkmcnt(0)" ::: "memory"); \
                    } \
                    float ps_ = 0.f; \
                    _Pragma("unroll") for (int i_ = 0; i_ < 16; ++i_) { P[i_] = __builtin_amdgcn_exp2f(P[i_]); ps_ += P[i_]; } \
                    lsum += ps_; \
                    _Pragma("unroll") for (int kk_ = 0; kk_ < 2; ++kk_) { u32x4 wv_; \
                        _Pragma("unroll") for (int j_ = 0; j_ < 4; ++j_) wv_[j_] = pk2(P[8 * kk_ + 2 * j_], P[8 * kk_ + 2 * j_ + 1]); \
                        const bf16x8 pfk_ = __builtin_bit_cast(bf16x8, wv_); \
                        if (MODE == 0 && kk_ == 0) { VKK_LOAD(vf[1], 2 * (HH) + 1); __builtin_amdgcn_sched_barrier(0); }     \
                        _Pragma("unroll") for (int dt_ = 0; dt_ < DT; ++dt_) o[dt_] = MFMA32(pfk_, vf[kk_][dt_], o[dt_]); } } while (0)
                    if constexpr (MODE != 0) {
                        HALF_STEP(pA, 0, _Pragma("unroll") for (int i_ = 0; i_ < 16; ++i_) pB[i_] -= dl);
                        HALF_STEP(pB, 1, (void)0);
                    } else {
                        HALF_STEP(pA, 0, (void)0);
#pragma unroll
                        for (int s = 0; s < 4; ++s) kfB[s] = *(const LAS bf16x8*)(Kt + (32 * KP + 16 * s));
                        __builtin_amdgcn_sched_barrier(0);
#pragma unroll
                        for (int s = 0; s < 4; ++s) { if (s == 0) pB = MFMA32(kfB[0], qf[0], negm); else pB = MFMA32(kfB[s], qf[s], pB); }
                        HALF_STEP(pB, 1, (void)0);
                    }
#undef HALF_STEP
#undef VKK_LOAD
#undef VFRAG_LOAD
                }
            } } }
#undef LOAD_TILE
#undef GLOAD16
#undef TILE_ROW
            float lt = halfsum(lsum);
            if (MODE == 2) lt += __builtin_amdgcn_exp2f(sink[hd] * 1.4426950408889634f - m);
            const float inv = 1.f / lt;
            if (h == 0) sc[r] = inv;
            asm volatile("s_waitcnt lgkmcnt(0)" ::: "memory");
#pragma unroll
            for (int g = 0; g < 4; ++g) { const f32x4 a4 = *(const LAS f32x4*)(sc + 8 * g + 4 * h);
#pragma unroll
                for (int dt = 0; dt < DT; ++dt)
#pragma unroll
                    for (int j = 0; j < 4; ++j) o[dt][4 * g + j] *= a4[j]; }
            asm volatile("s_waitcnt lgkmcnt(0)" ::: "memory");
            if (MODE == 0 && pass == 0) {
#pragma unroll
                for (int dt = 0; dt < DT; ++dt)
#pragma unroll
                    for (int j = 0; j < 8; ++j) stash[(dt * 8 + j) * 64 + lane] = pk2(o[dt][2 * j], o[dt][2 * j + 1]);
            }
        }
        if (MODE == 0) {
            float ssq[16];
#pragma unroll
            for (int i = 0; i < 16; ++i) ssq[i] = 0.f;
#pragma unroll
            for (int dt = 0; dt < DT; ++dt)
#pragma unroll
                for (int j = 0; j < 8; ++j) { const unsigned pk = stash[(dt * 8 + j) * 64 + lane];
                    const float a0 = bf_lo(pk) - lam * o[dt][2 * j], a1 = bf_hi(pk) - lam * o[dt][2 * j + 1];
                    o[dt][2 * j] = a0; o[dt][2 * j + 1] = a1; ssq[2 * j] += a0 * a0; ssq[2 * j + 1] += a1 * a1; }
#pragma unroll
            for (int i = 0; i < 16; ++i) {
#pragma unroll
                for (int off = 1; off < 32; off <<= 1) ssq[i] += __shfl_xor(ssq[i], off);
                ssq[i] = __builtin_amdgcn_rsqf(ssq[i] * (1.f / 128.f) + EPSN) * (1.f - lam_init); }
#pragma unroll
            for (int dt = 0; dt < DT; ++dt) { const float hg = head_g[32 * dt + r];
#pragma unroll
                for (int i = 0; i < 16; ++i) o[dt][i] *= ssq[i] * hg; }
        }
        { bf16_t* op = O + (size_t)(qrow0 + 32 * w) * DM + hd * DV + r;
#pragma unroll
          for (int dt = 0; dt < DT; ++dt)
#pragma unroll
              for (int i = 0; i < 16; ++i) { const int row = (i & 3) + 8 * (i >> 2) + 4 * h; op[(size_t)row * DM + 32 * dt] = (bf16_t)(pk2(o[dt][i], 0.f) & 0xffffu); } }
    }
}
#undef MFMA32
}
typedef unsigned short bf16;
typedef float f32x4 __attribute__((ext_vector_type(4)));
typedef unsigned v4u __attribute__((ext_vector_type(4)));
constexpr int NWAVES = 8, NTHREADS = 512;
constexpr size_t MiB = 1u << 20;
constexpr size_t WS_MOD = 0, WS_ROPE = 2 * MiB, WS_HB = 3 * MiB, WS_WQKV = 16 * MiB, WS_WO = 22 * MiB, WS_WUP = 24 * MiB, WS_WDN = 35 * MiB,
                 WS_X = 41 * MiB, WS_HN = 185 * MiB, WS_QKV = 257 * MiB, WS_END = 473 * MiB;
static_assert((size_t)DEPTH * NMODB * MODW * 4 <= 2 * MiB && (size_t)144 * 4 * NUP * 4 <= 13 * MiB && (size_t)NUP * DM * 2 <= 11 * MiB && (size_t)DM * DFF * 2 <= 6 * MiB, "ws map");
static_assert((size_t)MTOT * DM * 4 == 144 * MiB && (size_t)MTOT * DM * 2 == 72 * MiB && (size_t)MTOT * 3072 * 2 == 216 * MiB && (size_t)MTOT * DFF * 2 <= 216 * MiB, "ws map 2");
constexpr size_t WS_CTL = 2 * MiB + 768 * 1024, CTL_ZERO_BYTES = 16384;
constexpr int MISC_OFF = 163840 - 256;
constexpr int LDS_BYTES = 163840;

#ifndef PHM
#define PHM 0xffff
#endif
#ifndef X_SYNC
#define X_SYNC 0
#endif
#ifndef X_ATT
#define X_ATT 1
#endif
#ifndef X_UP
#define X_UP 1
#endif
#ifndef X_QKV
#define X_QKV 1
#endif
#ifndef X_NORM
#define X_NORM 1
#endif
#define GSYNC() do { XcdBarrier xb_ = xbar; unsigned* bp_ = (unsigned*)(a.ws + WS_CTL); asm volatile("" : "+s"(bp_)); xb_.bar = bp_;     \
    xcd_barrier(xb_); for (int xs_ = 0; xs_ < X_SYNC; ++xs_) xcd_barrier(xb_); } while (0)
#define GAS __attribute__((address_space(1)))
typedef GAS unsigned gu32;
typedef GAS unsigned long long gu64;
#define RLX_AGENT __ATOMIC_RELAXED, __HIP_MEMORY_SCOPE_AGENT
#define LDS_WAIT() asm volatile("s_waitcnt lgkmcnt(0)" ::: "memory")
#define VM_WAIT() asm volatile("s_waitcnt vmcnt(0)" ::: "memory")
__device__ __forceinline__ unsigned long long rt() { return __builtin_amdgcn_s_memrealtime(); }
#define XB_TMO      128
#define XB_XCNT(j)  (256  + 64 * (j))
#define XB_XSUB(j)  (1280 + 64 * (j))
#define XB_XGEN(j)  (2304 + 64 * (j))
#define XB_TOP      3328
#define XB_TOPGEN   3392
#define XCD_BAR_WORDS 3456
#define XB_SPIN_CAP (1u << 18)

__device__ __forceinline__ unsigned xb_ld(unsigned* p)              { return __hip_atomic_load(p, __ATOMIC_RELAXED, __HIP_MEMORY_SCOPE_AGENT); }
__device__ __forceinline__ unsigned xb_add(unsigned* p, unsigned v) { return __hip_atomic_fetch_add(p, v, __ATOMIC_RELAXED, __HIP_MEMORY_SCOPE_AGENT); }
__device__ __forceinline__ unsigned xb_xcc_id() { return (unsigned)__builtin_amdgcn_s_getreg((3 << 11) | 20) & 0xFu; }
#define XB_SPIN(cond, bar) do { unsigned _sp = 0; while (cond) { __builtin_amdgcn_s_sleep(1); \
    if ((++_sp & 255u) == 0u) { if (xb_ld(&(bar)[XB_TMO])) break; if (_sp > XB_SPIN_CAP) { atomicAdd(&(bar)[XB_TMO], 1u); break; } } } } while (0)

struct XcdBarrier {
    unsigned* bar; unsigned x;
    volatile LAS unsigned* st;
};

__device__ __forceinline__ XcdBarrier xcd_barrier_post(unsigned* bar, volatile LAS unsigned* st) {
    XcdBarrier b; b.bar = bar; b.x = xb_xcc_id(); b.st = st;
    if (threadIdx.x == 0) (void)xb_add(&bar[XB_XCNT(b.x)], 1u);
    return b;
}
__device__ __forceinline__ void xcd_barrier_complete(unsigned* bar, unsigned x, unsigned& nloc, unsigned& nx) {
    const unsigned G = gridDim.x * gridDim.y * gridDim.z;
    unsigned sum, cnt, mine, sp = 0u;
    for (;;) {
        sum = 0u; cnt = 0u; mine = 0u;
#pragma unroll
        for (unsigned j = 0; j < 16; ++j) { const unsigned c = xb_ld(&bar[XB_XCNT(j)]); sum += c; cnt += (c > 0u) ? 1u : 0u; mine = (j == x) ? c : mine; }
        if (sum == G) break;
        __builtin_amdgcn_s_sleep(1);
        if ((++sp & 255u) == 0u) { if (xb_ld(&bar[XB_TMO])) break; if (sp > XB_SPIN_CAP) { atomicAdd(&bar[XB_TMO], 1u); break; } }
    }
    nloc = mine > 0u ? mine : 1u; nx = cnt > 0u ? cnt : 1u;
}

__device__ __forceinline__ void xcd_barrier(const XcdBarrier& b) {
    asm volatile("s_waitcnt vmcnt(0)" ::: "memory");
    __syncthreads();
    if (threadIdx.x == 0) {
        unsigned* bar = b.bar;
        __builtin_amdgcn_s_waitcnt(0);
        unsigned nloc = b.st[0], nx = b.st[1];
        if (nloc == 0u) { xcd_barrier_complete(bar, b.x, nloc, nx); b.st[0] = nloc; b.st[1] = nx; }
        const unsigned old = xb_add(&bar[XB_XSUB(b.x)], 1u);
        const unsigned gen = old / nloc;
        if (old + 1u == (gen + 1u) * nloc) {
            __builtin_amdgcn_fence(__ATOMIC_RELEASE, "agent");
            asm volatile("s_waitcnt vmcnt(0)" ::: "memory");
            const unsigned og = xb_add(&bar[XB_TOP], 1u);
            const unsigned tg = og / nx;
            if (og + 1u == (tg + 1u) * nx) xb_add(&bar[XB_TOPGEN], 1u);
            else XB_SPIN(xb_ld(&bar[XB_TOPGEN]) == tg, bar);
            __builtin_amdgcn_fence(__ATOMIC_ACQUIRE, "agent");
            xb_add(&bar[XB_XGEN(b.x)], 1u);
            asm volatile("s_waitcnt vmcnt(0)" ::: "memory");
        } else {
            XB_SPIN(xb_ld(&bar[XB_XGEN(b.x)]) == gen, bar);
            __builtin_amdgcn_fence(__ATOMIC_ACQUIRE, "agent");
            asm volatile("s_waitcnt vmcnt(0)" ::: "memory");
        }
    }
    __syncthreads();
}

struct Args {
    const float *x, *c, *ctx, *c_ctx, *adaln_w, *adaln_b, *norm1_g, *norm2_g, *ffn_w_up, *ffn_conv_w, *ffn_conv_b, *ffn_w_down,
                *a_w_qkv, *a_qk_g, *a_lambda, *a_head_g, *a_w_o, *b_w_qkv, *b_qk_g, *b_w_o, *c_w_qkv, *c_qk_g, *c_sink, *c_w_o;
    float* out; unsigned char* ws;
};

#define DPP_F(x, ctrl) __int_as_float(__builtin_amdgcn_update_dpp(0, __float_as_int(x), (ctrl), 0xf, 0xf, false))
DI float wave_sum(float v) {
    v += DPP_F(v, 0xB1);
    v += DPP_F(v, 0x4E);
    v += DPP_F(v, 0x141);
    v += DPP_F(v, 0x140);
    v += __shfl_xor(v, 16);
    { auto rr = __builtin_amdgcn_permlane32_swap(__float_as_uint(v), __float_as_uint(v), false, false); v = __uint_as_float(rr[0]) + __uint_as_float(rr[1]); }
    return v;
}
DI void transpose_item(const float* W, int K, int N, bf16* WT, int k0, int n0, int dst_row0, LAS float* scr, int lane) {
    float wreg[32];
#pragma unroll
    for (int i = 0; i < 32; ++i) { const int kk = 2 * i + (lane >> 5); wreg[i] = W[(size_t)(k0 + kk) * N + n0 + (lane & 31)]; }
#pragma unroll
    for (int i = 0; i < 32; ++i) { const int kk = 2 * i + (lane >> 5); scr[kk * 33 + (lane & 31)] = wreg[i]; }
    asm volatile("s_waitcnt lgkmcnt(0)" ::: "memory");
    const int c = lane & 7;
#pragma unroll
    for (int j = 0; j < 4; ++j) { const int n = (lane >> 3) + 8 * j; const LAS float* s = scr + (8 * c) * 33 + n;
        v4u o; o.x = pk2(s[0 * 33], s[1 * 33]); o.y = pk2(s[2 * 33], s[3 * 33]); o.z = pk2(s[4 * 33], s[5 * 33]); o.w = pk2(s[6 * 33], s[7 * 33]);
        *(v4u*)(WT + (size_t)(dst_row0 + n) * K + k0 + 8 * c) = o; }
    asm volatile("s_waitcnt lgkmcnt(0)" ::: "memory");
}
DI void convert_weights(const Args& a, int layer, LAS unsigned char* lds, int gw, int NGW, int wave, int lane) {
    LAS float* scr = (LAS float*)(lds + wave * 16384);
    const int kind = layer % 3, j = layer / 3;
    const int NQ = kind == 0 ? 3072 : 1536;
    const float* wqkv = kind == 0 ? a.a_w_qkv + (size_t)j * DM * 3072 : (kind == 1 ? a.b_w_qkv : a.c_w_qkv) + (size_t)j * DM * 1536;
    const float* wo = (kind == 0 ? a.a_w_o : (kind == 1 ? a.b_w_o : a.c_w_o)) + (size_t)j * DM * DM;
    const float* wup = a.ffn_w_up + (size_t)layer * DM * NUP;
    const float* wdn = a.ffn_w_down + (size_t)layer * DFF * DM;
    bf16* Wqkv_t = (bf16*)(a.ws + WS_WQKV); bf16* Wo_t = (bf16*)(a.ws + WS_WO); bf16* Wup_t = (bf16*)(a.ws + WS_WUP); bf16* Wdn_t = (bf16*)(a.ws + WS_WDN);
    const int I_Q = (DM / 64) * (NQ / 32), I_O = (DM / 64) * (DM / 32), I_U = (DM / 64) * (NUP / 32), I_D = (DFF / 64) * (DM / 32);
    for (int it = gw; it < I_Q + I_O + I_U + I_D; it += NGW) {
        int r = it;
        if (r < I_Q) { const int nb = r % (NQ / 32), kb = r / (NQ / 32), tile = nb >> 3, bc = nb & 7;
            transpose_item(wqkv, DM, NQ, Wqkv_t, 64 * kb, 32 * nb, 256 * tile + 32 * (4 * (bc & 1) + (bc >> 1)), scr, lane); continue; }
        r -= I_Q;
        if (r < I_O) { const int nb = r % (DM / 32), kb = r / (DM / 32); transpose_item(wo, DM, DM, Wo_t, 64 * kb, 32 * nb, 32 * nb, scr, lane); continue; }
        r -= I_O;
        if (r < I_U) { const int nb = r % (NUP / 32), kb = r / (NUP / 32); const int n0 = 32 * nb, bj = n0 >= DFF ? 1 : 0, ch = n0 - bj * DFF;
            transpose_item(wup, DM, NUP, Wup_t, 64 * kb, n0, 256 * (ch >> 7) + 128 * bj + (ch & 127), scr, lane); continue; }
        r -= I_U;
        { const int nb = r % (DM / 32), kb = r / (DM / 32); transpose_item(wdn, DFF, DM, Wdn_t, 64 * kb, 32 * nb, 32 * nb, scr, lane); }
    }
}
DI void prologue(const Args& a, LAS unsigned char* lds, int tid, int wave, int lane, int G) {
    float* MOD = (float*)(a.ws + WS_MOD);
    LAS float* scl = (LAS float*)lds;
    LAS float* red = (LAS float*)(lds + 17 * 1024 * 4);
    for (int idx = tid; idx < NMODB * DM; idx += NTHREADS) { const int bb = idx >> 10, k = idx & 1023; const float v = bb < NBATCH ? a.c[bb * DM + k] : a.c_ctx[k]; scl[idx] = v / (1.f + expf(-v)); }
    __syncthreads();
#pragma unroll 1
    for (int task = blockIdx.x; task < DEPTH * (MODW / 64); task += G) {
        const int layer = task / (MODW / 64), n0 = (task % (MODW / 64)) * 64;
        const float* W = a.adaln_w + (size_t)layer * DM * MODW + n0 + lane;
        float acc[NMODB];
#pragma unroll
        for (int bb = 0; bb < NMODB; ++bb) acc[bb] = 0.f;
#pragma unroll 1
        for (int kk0 = 0; kk0 < 128; kk0 += 16) { float wv[16];
#pragma unroll
            for (int i = 0; i < 16; ++i) wv[i] = W[(size_t)(128 * wave + kk0 + i) * MODW];
#pragma unroll
            for (int i = 0; i < 16; ++i) { const int k = 128 * wave + kk0 + i;
#pragma unroll
                for (int bb = 0; bb < NMODB; ++bb) acc[bb] += scl[bb * DM + k] * wv[i]; } }
#pragma unroll
        for (int bb = 0; bb < NMODB; ++bb) red[(wave * NMODB + bb) * 64 + lane] = acc[bb];
        __syncthreads();
        for (int o = tid; o < NMODB * 64; o += NTHREADS) { const int bb = o >> 6, ln = o & 63; float s = a.adaln_b[layer * MODW + n0 + ln];
#pragma unroll
            for (int w8 = 0; w8 < 8; ++w8) s += red[(w8 * NMODB + bb) * 64 + ln];
            MOD[((size_t)layer * NMODB + bb) * MODW + n0 + ln] = s; }
        __syncthreads();
    }
    float* rcos = (float*)(a.ws + WS_ROPE); float* rsin = rcos + SEQL * 32;
    for (int idx = blockIdx.x * NTHREADS + tid; idx < SEQL * 32; idx += G * NTHREADS) { const int t = idx >> 5, jj = idx & 31, f = jj & 15; const float pos = (float)(jj < 16 ? (t >> 6) : (t & 63));
        const float inv = exp2f(-(float)f * (13.287712379549449f / 16.f)); const float ang = pos * inv; rcos[idx] = cosf(ang); rsin[idx] = sinf(ang); }
    __syncthreads();
    convert_weights(a, 0, lds, blockIdx.x * NWAVES + wave, G * NWAVES, wave, lane);
}
DI void norm_pass(const Args& a, int layer, int which, int nrows, int gw, int NGW, int lane) {
    const float* MOD = (const float*)(a.ws + WS_MOD) + (size_t)layer * NMODB * MODW;
    const bf16* Xb = (const bf16*)(a.ws + WS_X); bf16* HN = (bf16*)(a.ws + WS_HN);
    const float* g = (which == 1 ? a.norm1_g : a.norm2_g) + layer * DM;
    const int sh_off = which == 1 ? 0 : 3 * DM, sc_off = which == 1 ? DM : 4 * DM;
    const bool from_input = (layer == 0 && which == 1);
    const int R = (nrows + NGW - 1) / NGW, r0 = gw * R, r1 = (r0 + R < nrows) ? r0 + R : nrows;
    int cur_bb = -1; f32x4 gs[2][2], sh[2][2];
#pragma unroll
    for (int j = 0; j < 2; ++j)
#pragma unroll
        for (int k = 0; k < 2; ++k) { gs[j][k] = (f32x4){0.f, 0.f, 0.f, 0.f}; sh[j][k] = gs[j][k]; }
    for (int row = r0; row < r1; ++row) {
        const int bb = row < MLAT ? row >> 11 : NBATCH;
        f32x4 v[2][2]; float s = 0.f;
        if (from_input) { const float* src = row < MLAT ? a.x + (size_t)row * DM : a.ctx + (size_t)(row - MLAT) * DM;
#pragma unroll
            for (int j = 0; j < 2; ++j)
#pragma unroll
                for (int k = 0; k < 2; ++k) v[j][k] = *(const f32x4*)(src + 8 * (lane + 64 * j) + 4 * k); }
        else { const v4u* xr = (const v4u*)(Xb + (size_t)row * DM) + lane;
#pragma unroll
            for (int j = 0; j < 2; ++j) { const v4u r4 = xr[64 * j]; v[j][0] = (f32x4){bf_lo(r4.x), bf_hi(r4.x), bf_lo(r4.y), bf_hi(r4.y)}; v[j][1] = (f32x4){bf_lo(r4.z), bf_hi(r4.z), bf_lo(r4.w), bf_hi(r4.w)}; } }
        if (bb != cur_bb) { cur_bb = bb;
            const float* scp = MOD + (size_t)bb * MODW + sc_off; const float* shp = MOD + (size_t)bb * MODW + sh_off;
#pragma unroll
            for (int j = 0; j < 2; ++j)
#pragma unroll
                for (int k = 0; k < 2; ++k) { const int c = 8 * (lane + 64 * j) + 4 * k; gs[j][k] = *(const f32x4*)(g + c) * (*(const f32x4*)(scp + c) + 1.f); sh[j][k] = *(const f32x4*)(shp + c); } }
#pragma unroll
        for (int j = 0; j < 2; ++j)
#pragma unroll
            for (int k = 0; k < 2; ++k) s += (v[j][k].x * v[j][k].x + v[j][k].y * v[j][k].y) + (v[j][k].z * v[j][k].z + v[j][k].w * v[j][k].w);
        const float rstd = 1.f / sqrtf(wave_sum(s) * (1.f / DM) + EPSN);
        v4u* o16 = (v4u*)(HN + (size_t)row * DM) + lane;
#pragma unroll
        for (int j = 0; j < 2; ++j) { const f32x4 y0 = v[j][0] * rstd * gs[j][0] + sh[j][0], y1 = v[j][1] * rstd * gs[j][1] + sh[j][1];
            v4u w; w.x = pk2(y0.x, y0.y); w.y = pk2(y0.z, y0.w); w.z = pk2(y1.x, y1.y); w.w = pk2(y1.z, y1.w); o16[64 * j] = w; }
    }
}
DI void conv_fixup(const Args& a, int layer, int ntiles, int gt, int GT) {
    const float* HB = (const float*)(a.ws + WS_HB); bf16* ACT = (bf16*)(a.ws + WS_QKV);
    const float* cw = a.ffn_conv_w + (size_t)layer * 3 * NUP; const float* cb = a.ffn_conv_b + (size_t)layer * NUP;
    for (int idx = gt; idx < ntiles * 2 * (DFF / 4); idx += GT) {
        const int ch = (idx % (DFF / 4)) * 4, pe = idx / (DFF / 4), edge = pe & 1, pm = pe >> 1;
        const bool lat = pm < MLAT / 256; const bool start = lat ? (pm & 7) == 0 : true, end = lat ? (pm & 7) == 7 : true;
        const float* hb = HB + (size_t)pm * 4 * NUP;
        f32x4 cv[2];
#pragma unroll
        for (int hf = 0; hf < 2; ++hf) { const int col = hf * DFF + ch; f32x4 up, uc, un; const f32x4 z = (f32x4){0.f, 0.f, 0.f, 0.f};
            if (edge == 0) { up = start ? z : *(const f32x4*)(hb - NUP + col); uc = *(const f32x4*)(hb + col); un = *(const f32x4*)(hb + NUP + col); }
            else { up = *(const f32x4*)(hb + 2 * NUP + col); uc = *(const f32x4*)(hb + 3 * NUP + col); un = end ? z : *(const f32x4*)(hb + 4 * NUP + col); }
            cv[hf] = *(const f32x4*)(cw + col) * up + *(const f32x4*)(cw + NUP + col) * uc + *(const f32x4*)(cw + 2 * NUP + col) * un + *(const f32x4*)(cb + col); }
        uint2 w; w.x = pk2(silu_f(cv[0].x) * cv[1].x, silu_f(cv[0].y) * cv[1].y); w.y = pk2(silu_f(cv[0].z) * cv[1].z, silu_f(cv[0].w) * cv[1].w);
        *(uint2*)(ACT + (size_t)(256 * pm + (edge ? 255 : 0)) * DFF + ch) = w;
    }
}

DI unsigned char* ws_opaque(unsigned char* p) { asm volatile("" : "+s"(p)); return p; }
#define WSB ws_opaque(a.ws)
#define MODp ((float*)(WSB + WS_MOD))
#define rcos ((const float*)(WSB + WS_ROPE))
#define rsin ((const float*)(WSB + WS_ROPE) + SEQL * 32)
#define X ((bf16*)(WSB + WS_X))
#define HN ((bf16*)(WSB + WS_HN))
#define QKV ((bf16*)(WSB + WS_QKV))
#define ACT ((bf16*)(WSB + WS_QKV))
#define HB ((float*)(WSB + WS_HB))
#define Wqkv_t ((bf16*)(WSB + WS_WQKV))
#define Wo_t ((bf16*)(WSB + WS_WO))
#define Wup_t ((bf16*)(WSB + WS_WUP))
#define Wdn_t ((bf16*)(WSB + WS_WDN))
__global__ void __launch_bounds__(NTHREADS, 2) fwd_mega(Args a) {
    extern __shared__ __attribute__((aligned(16))) unsigned char lds_raw[];
    LAS unsigned char* lds = (LAS unsigned char*)lds_raw;
    cg::grid_group grid = cg::this_grid();
    const int G = gridDim.x, bx = blockIdx.x;
    const int wave0 = __builtin_amdgcn_readfirstlane((int)threadIdx.x >> 6);
    const int vb = (G % 8 == 0) ? (bx % 8) * (G / 8) + bx / 8 : bx;
    const int NGW = G * NWAVES, GT = G * NTHREADS;
#define PHASE_IDS() int tid = wave0 * 64 + lane_id_opaque(); asm volatile("" : "+v"(tid)); const int lane = tid & 63, wave = __builtin_amdgcn_readfirstlane(tid >> 6), gw = bx * NWAVES + wave, gt = bx * NTHREADS + tid; (void)lane; (void)wave; (void)gw; (void)gt

    if (threadIdx.x < 16) ((LAS unsigned*)(lds + MISC_OFF))[threadIdx.x] = 0u;
    __syncthreads();
    const XcdBarrier xbar = xcd_barrier_post((unsigned*)(a.ws + WS_CTL), (volatile LAS unsigned*)(lds + MISC_OFF));
    if (PHM & 1) { PHASE_IDS(); prologue(a, lds, tid, wave, lane, G); }
    grid.sync();
#pragma unroll 1
    for (int layer = 0; layer < DEPTH; ++layer) {
        const int kind = layer % 3, j = layer / 3; const bool last = layer == DEPTH - 1;
        const int NQ = kind == 0 ? 3072 : 1536, MR = last ? MLAT : MTOT;
        const float* MODl = MODp + (size_t)layer * NMODB * MODW;
        if (PHM & 2) { PHASE_IDS(); if (layer > 0) { __syncthreads(); convert_weights(a, layer, lds, gw, NGW, wave, lane); }
            for (int xn_ = 0; xn_ < X_NORM; ++xn_) norm_pass(a, layer, 1, MTOT, gw, NGW, lane); }
        GSYNC();
        for (int xq_ = 0; xq_ < X_QKV; ++xq_)
        if (PHM & 4) { pg8::Gemm g{HN, Wqkv_t, MTOT, NQ, DM}; pg8::StaticOrder S; S.init(MTOT, NQ, G, bx);
          const float* qkg = (kind == 0 ? a.a_qk_g : (kind == 1 ? a.b_qk_g : a.c_qk_g)) + j * 128;
          pg8::EpiQKV E{QKV, NQ, qkg, qkg + 64, rcos, rsin, 4, kind == 0 ? 4 : 1};
          pg8::gemm_phase<pg8::EpiQKV, pg8::StaticOrder, true, true>(lds, g, S, E, wave0); }
        GSYNC();
        for (int xa_ = 0; xa_ < X_ATT; ++xa_)
        if (!(PHM & 8)) {} else if (kind == 0) att::attn_phase<0>(lds, QKV, NQ, HN, a.a_lambda + j * 256, a.a_head_g + j * 128, 0.8f - 0.6f * expf(-0.3f * (float)layer), nullptr, !last, vb, G, wave0);
        else if (kind == 1 && (PHM & 16)) att::attn_phase<1>(lds, QKV, NQ, HN, nullptr, nullptr, 0.f, nullptr, !last, vb, G, wave0);
        else if (PHM & 32) att::attn_phase<2>(lds, QKV, NQ, HN, nullptr, nullptr, 0.f, a.c_sink + j * 16, !last, vb, G, wave0);
        GSYNC();
        if (PHM & 64) { pg8::Gemm g{HN, Wo_t, MR, DM, DM}; pg8::StaticOrder S; S.init(MR, DM, G, bx);
          pg8::EpiResid E{a.x, a.ctx - (size_t)MLAT * DM, layer == 0 ? (const bf16*)nullptr : (const bf16*)X, X, (float*)nullptr, MODl + 2 * DM};
          pg8::gemm_phase<pg8::EpiResid, pg8::StaticOrder, true, true>(lds, g, S, E, wave0); }
        GSYNC();
        if (PHM & 128) { PHASE_IDS(); for (int xn_ = 0; xn_ < X_NORM; ++xn_) norm_pass(a, layer, 2, MR, gw, NGW, lane); }
        GSYNC();
        for (int xu_ = 0; xu_ < X_UP; ++xu_)
        if (PHM & 256) { pg8::Gemm g{HN, Wup_t, MR, NUP, DM}; pg8::StaticOrder S; S.init(MR, NUP, G, bx);
          pg8::EpiConv E{ACT, HB, a.ffn_conv_w + (size_t)layer * 3 * NUP, a.ffn_conv_b + (size_t)layer * NUP};
          pg8::gemm_phase<pg8::EpiConv, pg8::StaticOrder, true, true>(lds, g, S, E, wave0); }
        GSYNC();
        if (PHM & 512) { PHASE_IDS(); conv_fixup(a, layer, MR / 256, gt, GT); }
        GSYNC();
        if (PHM & 1024) { pg8::Gemm g{ACT, Wdn_t, MR, DM, DFF}; pg8::StaticOrder S; S.init(MR, DM, G, bx);
          pg8::EpiResid E{a.x, a.ctx, (const bf16*)X, X, last ? a.out : (float*)nullptr, MODl + 5 * DM};
          pg8::gemm_phase<pg8::EpiResid, pg8::StaticOrder, true, true>(lds, g, S, E, wave0); }
        if (!last) GSYNC();
    }
}

extern "C" void kernel_launch(void* const* d_in, const int* in_sizes, int n_in, void* d_out, int out_size, void* d_ws, size_t ws_size, hipStream_t stream) {
    static int grid = 0;
    if (grid == 0) {
        int dev = 0, cus = 0, per_cu = 0;
        if (n_in != 24 || out_size != MLAT * DM || ws_size < WS_END) { fprintf(stderr, "kernel_launch: unexpected shapes n_in %d out %d ws %zu\n", n_in, out_size, ws_size); grid = -1; return; }
        (void)hipGetDevice(&dev); (void)hipDeviceGetAttribute(&cus, hipDeviceAttributeMultiprocessorCount, dev);
        (void)hipFuncSetAttribute((const void*)fwd_mega, hipFuncAttributeMaxDynamicSharedMemorySize, LDS_BYTES);
        (void)hipOccupancyMaxActiveBlocksPerMultiprocessor(&per_cu, (const void*)fwd_mega, NTHREADS, LDS_BYTES);
        if (per_cu < 1) per_cu = 1;
        grid = cus * per_cu;
        fprintf(stderr, "kernel_launch: cus %d per_cu %d grid %d ws %zu\n", cus, per_cu, grid, ws_size);
    }
    if (grid < 0) return;
    if (hipMemsetAsync((char*)d_ws + WS_CTL, 0, CTL_ZERO_BYTES, stream) != hipSuccess) { fprintf(stderr, "kernel_launch: memset failed\n"); return; }
    Args a{};
    const float** ap = (const float**)&a;
    for (int i = 0; i < 24; ++i) ap[i] = (const float*)d_in[i];
    a.out = (float*)d_out; a.ws = (unsigned char*)d_ws;
    void* args[] = {&a};
    hipError_t e = hipLaunchCooperativeKernel((const void*)fwd_mega, dim3(grid), dim3(NTHREADS), args, LDS_BYTES, stream);
    if (e != hipSuccess) fprintf(stderr, "cooperative launch failed: %s (grid %d)\n", hipGetErrorString(e), grid);
}
```
